# Optimizing an MI355X kernel written in HIP

```python
import math
import jax
import jax.numpy as jnp
from jax import lax
import numpy as np

D_MODEL = 2048
BATCH = 4
SEQ = 4096
DEPTH = 2

HEAD_DIM = 128
D_FF = 5632
PLE_DIM = 256
ROPE_THETA = 10000.0
NORM_EPS = 1e-6
Q_BLOCK = 128
GATHER_Q_BLOCK = 64

A_HEADS = 8
A_QK_DIM = 64
A_V_DIM = 2 * A_QK_DIM
B_GROUPS = ((128, 1), (512, 4), (2048, 16))
B_HEADS_PER_GROUP = 4
B_HEADS = B_HEADS_PER_GROUP * len(B_GROUPS)
C_HEADS = 8
C_Q_LORA = 512
C_KV_LORA = 256
C_NOPE = 128
C_ROPE = 64
C_V = 128
D_HEADS = 8
MOBA_BLOCK = 256
MOBA_TOPK = 3

A_Q_WIDTH = A_HEADS * 2 * A_QK_DIM
A_V_WIDTH = A_HEADS * A_V_DIM
B_WIDTH = B_HEADS * HEAD_DIM
AB_SPLITS = (A_Q_WIDTH, A_Q_WIDTH, A_V_WIDTH, B_WIDTH, B_WIDTH, B_WIDTH)
AB_IN = sum(AB_SPLITS)
AB_OUT = A_V_WIDTH + B_HEADS_PER_GROUP * HEAD_DIM
D_WIDTH = D_HEADS * HEAD_DIM
CD_SPLITS = (C_Q_LORA, C_KV_LORA, C_ROPE, D_WIDTH, D_WIDTH, D_WIDTH)
CD_IN = sum(CD_SPLITS)
CD_OUT = C_HEADS * C_V + D_WIDTH

kernel_name = 'hybrid_diff_dilated_mla_moba_block'


def rms_norm(x, gain):
    xf = x.astype(jnp.float32)
    xf = xf * lax.rsqrt(jnp.mean(xf * xf, axis=-1, keepdims=True) + NORM_EPS)
    return (xf * gain.astype(jnp.float32)).astype(x.dtype)


def rope_tables(seq, dim):
    inv = 1.0 / (ROPE_THETA ** (jnp.arange(0, dim, 2, dtype=jnp.float32) / dim))
    ang = jnp.arange(seq, dtype=jnp.float32)[:, None] * inv[None, :]
    return jnp.cos(ang), jnp.sin(ang)


def apply_rope(x, cos, sin):
    x1, x2 = jnp.split(x, 2, axis=-1)
    c = cos.astype(x.dtype)
    s = sin.astype(x.dtype)
    return jnp.concatenate([x1 * c - x2 * s, x2 * c + x1 * s], axis=-1)


def split_cols(z, sizes):
    return jnp.split(z, np.cumsum(sizes)[:-1].tolist(), axis=-1)


def swiglu(h, w_gu, w_down):
    g, u = jnp.split(h @ w_gu, 2, axis=-1)
    return (jax.nn.silu(g) * u) @ w_down


def sweep_query_blocks(block_fn, seq, block):
    out = lax.map(block_fn, jnp.arange(seq // block))
    n, b, h, t, d = out.shape
    return jnp.moveaxis(out, 0, 2).reshape(b, h, n * t, d)


def causal_attention(q, k, v, scale):
    s = q.shape[2]
    kpos = jnp.arange(s)

    def block(i):
        q0 = i * Q_BLOCK
        qb = lax.dynamic_slice_in_dim(q, q0, Q_BLOCK, axis=2)
        qpos = q0 + jnp.arange(Q_BLOCK)
        sc = jnp.einsum('bhqd,bhkd->bhqk', qb, k).astype(jnp.float32) * scale
        sc = jnp.where(kpos[None, :] <= qpos[:, None], sc, -jnp.inf)
        pr = jax.nn.softmax(sc, axis=-1).astype(v.dtype)
        return jnp.einsum('bhqk,bhkd->bhqd', pr, v)

    return sweep_query_blocks(block, s, Q_BLOCK)


def diff_attention(q, k, v, lam, scale):
    s = v.shape[2]
    kpos = jnp.arange(s)

    def block(i):
        q0 = i * Q_BLOCK
        qb = lax.dynamic_slice_in_dim(q, q0, Q_BLOCK, axis=3)
        qpos = q0 + jnp.arange(Q_BLOCK)
        sc = jnp.einsum('bhmqd,bhmkd->bhmqk', qb, k).astype(jnp.float32) * scale
        sc = jnp.where(kpos[None, :] <= qpos[:, None], sc, -jnp.inf)
        pr = jax.nn.softmax(sc, axis=-1)
        attn = (pr[:, :, 0] - lam * pr[:, :, 1]).astype(v.dtype)
        return jnp.einsum('bhqk,bhkd->bhqd', attn, v)

    return sweep_query_blocks(block, s, Q_BLOCK)


def dilated_window_attention(q, k, v):
    b, _, s, d = q.shape
    n_g = len(B_GROUPS)
    qg_all = q.reshape(b, n_g, B_HEADS_PER_GROUP, s, d)
    kg_all = k.reshape(b, n_g, B_HEADS_PER_GROUP, s, d)
    vg_all = v.reshape(b, n_g, B_HEADS_PER_GROUP, s, d)
    scale = d ** -0.5

    def block(i):
        q0 = i * GATHER_Q_BLOCK
        qpos = q0 + jnp.arange(GATHER_Q_BLOCK)
        outs, lses = [], []
        for g, (window, dil) in enumerate(B_GROUPS):
            n_keys = window // dil + 1
            idx = qpos[:, None] - dil * jnp.arange(n_keys)[None, :]
            valid = idx >= 0
            idx = jnp.maximum(idx, 0)
            qb = lax.dynamic_slice_in_dim(qg_all[:, g], q0, GATHER_Q_BLOCK, axis=2)
            kb = jnp.take(kg_all[:, g], idx, axis=2)
            vb = jnp.take(vg_all[:, g], idx, axis=2)
            sc = jnp.einsum('bhqd,bhqnd->bhqn', qb, kb).astype(jnp.float32) * scale
            sc = jnp.where(valid, sc, -jnp.inf)
            lse = jax.nn.logsumexp(sc, axis=-1)
            pr = jnp.exp(sc - lse[..., None]).astype(v.dtype)
            outs.append(jnp.einsum('bhqn,bhqnd->bhqd', pr, vb))
            lses.append(lse)
        wts = jax.nn.softmax(jnp.stack(lses), axis=0).astype(v.dtype)
        return jnp.einsum('gbhq,gbhqd->bhqd', wts, jnp.stack(outs))

    return sweep_query_blocks(block, s, GATHER_Q_BLOCK)


def moba_attention(q, k, v):
    b, h, s, d = q.shape
    scale = d ** -0.5
    n_blk = -(-s // MOBA_BLOCK)
    pad = n_blk * MOBA_BLOCK - s
    widths = ((0, 0), (0, 0), (0, pad), (0, 0))
    k_pad = jnp.pad(k, widths)
    v_pad = jnp.pad(v, widths)
    k_blocks = k_pad.reshape(b, h, n_blk, MOBA_BLOCK, d)
    v_blocks = v_pad.reshape(b, h, n_blk, MOBA_BLOCK, d)
    k_mean = jnp.mean(k_blocks.astype(jnp.float32), axis=3).astype(k.dtype)
    top_k = min(MOBA_TOPK, n_blk - 1)
    n_sel = top_k * MOBA_BLOCK
    b_idx = jnp.arange(b)[:, None, None, None]
    h_idx = jnp.arange(h)[None, :, None, None]

    def block(i):
        q0 = i * GATHER_Q_BLOCK
        qpos = q0 + jnp.arange(GATHER_Q_BLOCK)
        own = q0 // MOBA_BLOCK
        qb = lax.dynamic_slice_in_dim(q, q0, GATHER_Q_BLOCK, axis=2)
        k_own = lax.dynamic_slice_in_dim(k_pad, own * MOBA_BLOCK, MOBA_BLOCK, axis=2)
        v_own = lax.dynamic_slice_in_dim(v_pad, own * MOBA_BLOCK, MOBA_BLOCK, axis=2)
        kpos = own * MOBA_BLOCK + jnp.arange(MOBA_BLOCK)
        s_own = jnp.einsum('bhqd,bhkd->bhqk', qb, k_own).astype(jnp.float32) * scale
        s_own = jnp.where(kpos[None, :] <= qpos[:, None], s_own, -jnp.inf)
        if top_k == 0:
            pr = jax.nn.softmax(s_own, axis=-1).astype(v.dtype)
            return jnp.einsum('bhqk,bhkd->bhqd', pr, v_own)
        gate = jnp.einsum('bhqd,bhnd->bhqn', qb, k_mean).astype(jnp.float32)
        gate = jnp.where(jnp.arange(n_blk) < own, gate, -jnp.inf)
        _, sel = lax.top_k(gate, top_k)
        sel_ok = sel < own
        k_sel = k_blocks[b_idx, h_idx, sel]
        v_sel = v_blocks[b_idx, h_idx, sel].reshape(b, h, GATHER_Q_BLOCK, n_sel, d)
        s_sel = jnp.einsum('bhqd,bhqnld->bhqnl', qb, k_sel).astype(jnp.float32) * scale
        s_sel = jnp.where(sel_ok[..., None], s_sel, -jnp.inf).reshape(b, h, GATHER_Q_BLOCK, n_sel)
        pr = jax.nn.softmax(jnp.concatenate([s_sel, s_own], axis=-1), axis=-1).astype(v.dtype)
        return (jnp.einsum('bhqn,bhqnd->bhqd', pr[..., :n_sel], v_sel)
                + jnp.einsum('bhqk,bhkd->bhqd', pr[..., n_sel:], v_own))

    return sweep_query_blocks(block, s, GATHER_Q_BLOCK)


def ab_mixer(h, w_in, lam_params, subln, w_out, layer_idx, rope64, rope128):
    b, s, _ = h.shape
    qa, ka, va, qb, kb, vb = split_cols(h @ w_in, AB_SPLITS)
    qa = apply_rope(qa.reshape(b, s, A_HEADS, 2, A_QK_DIM).transpose(0, 2, 3, 1, 4), *rope64)
    ka = apply_rope(ka.reshape(b, s, A_HEADS, 2, A_QK_DIM).transpose(0, 2, 3, 1, 4), *rope64)
    va = va.reshape(b, s, A_HEADS, A_V_DIM).transpose(0, 2, 1, 3)
    lam_init = 0.8 - 0.6 * math.exp(-0.3 * layer_idx)
    lp = lam_params.astype(jnp.float32)
    lam = jnp.exp(jnp.sum(lp[0] * lp[1])) - jnp.exp(jnp.sum(lp[2] * lp[3])) + lam_init
    oa = diff_attention(qa, ka, va, lam, A_QK_DIM ** -0.5)
    oa = rms_norm(oa, subln) * (1.0 - lam_init)
    qb = apply_rope(qb.reshape(b, s, B_HEADS, HEAD_DIM).transpose(0, 2, 1, 3), *rope128)
    kb = apply_rope(kb.reshape(b, s, B_HEADS, HEAD_DIM).transpose(0, 2, 1, 3), *rope128)
    vb = vb.reshape(b, s, B_HEADS, HEAD_DIM).transpose(0, 2, 1, 3)
    ob = dilated_window_attention(qb, kb, vb)
    o = jnp.concatenate([oa, ob], axis=1).transpose(0, 2, 1, 3).reshape(b, s, AB_OUT)
    return o @ w_out


def cd_mixer(h, w_in, q_norm, w_uq, kv_norm, w_ukv, w_out, rope64, rope128):
    b, s, _ = h.shape
    c_q, c_kv, k_rope, qd, kd, vd = split_cols(h @ w_in, CD_SPLITS)
    qc = (rms_norm(c_q, q_norm) @ w_uq).reshape(b, s, C_HEADS, C_NOPE + C_ROPE).transpose(0, 2, 1, 3)
    kv = (rms_norm(c_kv, kv_norm) @ w_ukv).reshape(b, s, C_HEADS, C_NOPE + C_V).transpose(0, 2, 1, 3)
    k_rope = apply_rope(k_rope, *rope64)[:, None]
    qc = jnp.concatenate([qc[..., :C_NOPE], apply_rope(qc[..., C_NOPE:], *rope64)], axis=-1)
    kc = jnp.concatenate([kv[..., :C_NOPE], jnp.broadcast_to(k_rope, (b, C_HEADS, s, C_ROPE))], axis=-1)
    oc = causal_attention(qc, kc, kv[..., C_NOPE:], (C_NOPE + C_ROPE) ** -0.5)
    qd = apply_rope(qd.reshape(b, s, D_HEADS, HEAD_DIM).transpose(0, 2, 1, 3), *rope128)
    kd = apply_rope(kd.reshape(b, s, D_HEADS, HEAD_DIM).transpose(0, 2, 1, 3), *rope128)
    vd = vd.reshape(b, s, D_HEADS, HEAD_DIM).transpose(0, 2, 1, 3)
    od = moba_attention(qd, kd, vd)
    o = jnp.concatenate([oc, od], axis=1).transpose(0, 2, 1, 3).reshape(b, s, CD_OUT)
    return o @ w_out


def setup_inputs(seed: int = 0) -> dict:
    key = jax.random.key(seed)
    ks = jax.random.split(key, 20)
    n_even = (DEPTH + 1) // 2
    n_odd = DEPTH // 2
    f32 = jnp.float32

    def dense(k, shape):
        return jax.random.normal(k, shape, f32) * (shape[-2] ** -0.5)

    def gain(k, shape):
        return 1.0 + 0.02 * jax.random.normal(k, shape, f32)

    return {
        'x': jax.random.normal(ks[0], (BATCH, SEQ, D_MODEL), f32),
        'p': jax.random.normal(ks[1], (DEPTH, BATCH, SEQ, PLE_DIM), f32),
        'ffn_norm': gain(ks[2], (DEPTH, 2, D_MODEL)),
        'ffn_w_gu': dense(ks[3], (DEPTH, 2, D_MODEL, 2 * D_FF)),
        'ffn_w_down': dense(ks[4], (DEPTH, 2, D_FF, D_MODEL)),
        'mix_norm': gain(ks[5], (DEPTH, D_MODEL)),
        'ab_w_in': dense(ks[6], (n_even, D_MODEL, AB_IN)),
        'ab_lambda': 0.1 * jax.random.normal(ks[7], (n_even, 4, A_QK_DIM), f32),
        'ab_subln': gain(ks[8], (n_even, A_V_DIM)),
        'ab_w_out': dense(ks[9], (n_even, AB_OUT, D_MODEL)),
        'cd_w_in': dense(ks[10], (n_odd, D_MODEL, CD_IN)),
        'cd_q_norm': gain(ks[11], (n_odd, C_Q_LORA)),
        'cd_w_uq': dense(ks[12], (n_odd, C_Q_LORA, C_HEADS * (C_NOPE + C_ROPE))),
        'cd_kv_norm': gain(ks[13], (n_odd, C_KV_LORA)),
        'cd_w_ukv': dense(ks[14], (n_odd, C_KV_LORA, C_HEADS * (C_NOPE + C_V))),
        'cd_w_out': dense(ks[15], (n_odd, CD_OUT, D_MODEL)),
        'ple_norm': gain(ks[16], (DEPTH, D_MODEL)),
        'ple_w_gate': dense(ks[17], (DEPTH, D_MODEL, D_MODEL)),
        'ple_w_proj': dense(ks[18], (DEPTH, PLE_DIM, D_MODEL)),
        'final_norm': gain(ks[19], (D_MODEL,)),
    }


def reference(x, p, ffn_norm, ffn_w_gu, ffn_w_down, mix_norm, ab_w_in, ab_lambda, ab_subln, ab_w_out,
              cd_w_in, cd_q_norm, cd_w_uq, cd_kv_norm, cd_w_ukv, cd_w_out, ple_norm, ple_w_gate,
              ple_w_proj, final_norm):
    s = x.shape[1]
    rope64 = rope_tables(s, 64)
    rope128 = rope_tables(s, HEAD_DIM)
    for i in range(DEPTH):
        j = i // 2
        x = x + 0.5 * swiglu(rms_norm(x, ffn_norm[i, 0]), ffn_w_gu[i, 0], ffn_w_down[i, 0])
        h = rms_norm(x, mix_norm[i])
        if i % 2 == 0:
            x = x + ab_mixer(h, ab_w_in[j], ab_lambda[j], ab_subln[j], ab_w_out[j], i, rope64, rope128)
        else:
            x = x + cd_mixer(h, cd_w_in[j], cd_q_norm[j], cd_w_uq[j], cd_kv_norm[j], cd_w_ukv[j],
                             cd_w_out[j], rope64, rope128)
        x = x + 0.5 * swiglu(rms_norm(x, ffn_norm[i, 1]), ffn_w_gu[i, 1], ffn_w_down[i, 1])
        gate = jax.nn.sigmoid(rms_norm(x, ple_norm[i]) @ ple_w_gate[i])
        x = x + gate * (p[i] @ ple_w_proj[i])
    return rms_norm(x, final_norm)
```

```cpp
#include <hip/hip_runtime.h>
#include <hip/hip_cooperative_groups.h>
#include <cstdio>
#include <cstdint>
#include <cmath>
namespace cg = cooperative_groups;
namespace pg8 {
#define PG8_LAS __attribute__((address_space(3)))
typedef unsigned short bf16_t;
typedef short bf16x8 __attribute__((ext_vector_type(8)));
typedef float f32x4 __attribute__((ext_vector_type(4)));
typedef unsigned u32x4 __attribute__((ext_vector_type(4)));
constexpr int BM = 256, BK = 64, HALF = 128, HTB = HALF * BK * 2  , STAGE_BYTES = 8 * HTB, NXCD = 8, WGM = 8;

__host__ __device__ __forceinline__ int lds_byte(int r, int c) { const int st = (r >> 4) * 2 + (c >> 5), rr = r & 15, cc = c & 31, ob = rr * 64 + cc * 2; return st * 1024 + (ob ^ (((ob >> 9) & 1) << 5)); }
__host__ __device__ __forceinline__ void stage_rc(int b, int& R, int& C) { const int st = b / 1024, sb = b % 1024, swz = sb ^ (((sb >> 9) & 1) << 5); R = (st >> 1) * 16 + swz / 64; C = (st & 1) * 32 + (swz % 64) / 2; }
__host__ __device__ __forceinline__ int perm32(int rho) { const int n = rho >> 4, i = rho & 15; return 8 * (i >> 2) + 4 * n + (i & 3); }

struct Unit { int pm, pn; };
struct Gemm { const bf16_t* A; const bf16_t* Bt; int M, N, K; };

struct StaticOrder {
    int nM, nN, nwg, G, c;
    __host__ __device__ void init(int M, int N, int G_, int c_) { nM = M / BM; nN = N / BM; nwg = nM * nN; G = G_; c = c_; }
    __host__ __device__ bool next(int i, Unit& u) const {
        const long L = (long)i * G + c; if (L >= nwg) return false;
        int wgid = (int)L; { const int q = nwg / NXCD, r = nwg % NXCD, xcd = wgid % NXCD, off = wgid / NXCD; wgid = (xcd < r ? xcd * (q + 1) : r * (q + 1) + (xcd - r) * q) + off; }
        const int nig = WGM * nN, gid = wgid / nig, fm = gid * WGM, gsz = (nM - fm) < WGM ? (nM - fm) : WGM;
        u.pm = fm + ((wgid % nig) % gsz); u.pn = (wgid % nig) / gsz; return true;
    }
    __device__ __forceinline__ void a_ready(const Unit&) const {}
    __device__ __forceinline__ void done(const Unit&) const {}
};

__device__ __forceinline__ unsigned cvt_pk_bf16(float lo, float hi) { unsigned r; asm volatile("v_cvt_pk_bf16_f32 %0, %1, %2" : "=v"(r) : "v"(lo), "v"(hi)); return r; }
typedef float f32x2 __attribute__((ext_vector_type(2)));
constexpr float RMS_INV_D = 1.0f / 2048.0f, RMS_EPS = 1e-6f;
typedef __attribute__((address_space(3))) float lds_f32;
__device__ __forceinline__ lds_f32* stats_tab() { return (lds_f32*)(size_t)(147456 - 4096); }
__device__ __forceinline__ void stats_table(const float* ss, int base, int tid) {
    typedef __attribute__((address_space(3))) int lds_i32;
    lds_i32* tag = (lds_i32*)(stats_tab() + 256);
    const int want = (int)((size_t)ss >> 7) + base;
    const int have = __builtin_amdgcn_readfirstlane(*tag);
    if (have == want) return;
    const f32x4* p = (const f32x4*)(ss + (size_t)(base + (tid >> 1)) * 32 + (tid & 1) * 16);
    const f32x4 a = (p[0] + p[1]) + (p[2] + p[3]);
    float s = (a[0] + a[1]) + (a[2] + a[3]);
    s += __int_as_float(__builtin_amdgcn_ds_bpermute(((tid & 63) ^ 1) << 2, __float_as_int(s)));
    if ((tid & 1) == 0) stats_tab()[tid >> 1] = __builtin_amdgcn_rsqf(s * RMS_INV_D + RMS_EPS);
    asm volatile("s_waitcnt lgkmcnt(0)\n\ts_barrier" ::: "memory");
    if (tid == 0) *tag = want;
}
struct EpiStore {
    static constexpr bool PERM = true, AFTER_DRAIN = false;
    bf16_t* O; int ldc; const float* rs; const float* cs;
    __device__ __forceinline__ void operator()(const f32x4 (&acc)[2][2][4][2], const Unit& u, int wr, int wc, int fr, int fq) const {
        const int row0 = u.pm * BM + wr * 64 + fr; const int col0 = u.pn * BM + wc * 32 + 8 * fq;
        const int tid = (wr * 4 + wc) * 64 + fq * 16 + fr;
        if (rs) stats_table(rs, u.pm * BM, tid); else if (cs) stats_table(cs, u.pn * BM, tid);
        const lds_f32* tab = stats_tab();
        float cv[2][8];
#pragma unroll
        for (int bj = 0; bj < 2; ++bj)
#pragma unroll
            for (int e = 0; e < 8; ++e) cv[bj][e] = cs ? tab[wc * 32 + 8 * fq + bj * HALF + e] : 1.0f;
#pragma unroll
        for (int ai = 0; ai < 2; ++ai)
#pragma unroll
            for (int m = 0; m < 4; ++m) { const int rl = wr * 64 + fr + ai * HALF + m * 16; bf16_t* rowp = O + (size_t)(u.pm * BM + rl) * ldc + col0; const float rsc = rs ? tab[rl] : 1.0f;
#pragma unroll
                for (int bj = 0; bj < 2; ++bj) { const f32x4 v0 = acc[ai][bj][m][0] * rsc, v1 = acc[ai][bj][m][1] * rsc;
                    u32x4 w; w.x = cvt_pk_bf16(v0[0] * cv[bj][0], v0[1] * cv[bj][1]); w.y = cvt_pk_bf16(v0[2] * cv[bj][2], v0[3] * cv[bj][3]);
                    w.z = cvt_pk_bf16(v1[0] * cv[bj][4], v1[1] * cv[bj][5]); w.w = cvt_pk_bf16(v1[2] * cv[bj][6], v1[3] * cv[bj][7]);
                    *(u32x4*)(rowp + bj * HALF) = w; } }
    }
};
struct EpiRope {
    static constexpr bool PERM = true, AFTER_DRAIN = false;
    bf16_t* O; int ldc; const float* rs; const float* cs; const float* sn; int half;
    __device__ __forceinline__ void operator()(const f32x4 (&acc)[2][2][4][2], const Unit& u, int wr, int wc, int fr, int fq) const {
        typedef unsigned u32x2 __attribute__((ext_vector_type(2)));
        const int tid = (wr * 4 + wc) * 64 + fq * 16 + fr;
        stats_table(rs, u.pm * BM, tid); const lds_f32* tab = stats_tab();
        const int d0 = (half == 64) ? 16 * wc + 4 * fq : 16 * (wc & 1) + 4 * fq;
        const int gcol = u.pn * BM + ((half == 64) ? 0 : 64 * (wc >> 1)) + d0;
#pragma unroll
        for (int ai = 0; ai < 2; ++ai)
#pragma unroll
            for (int m = 0; m < 4; ++m) { const int rl = wr * 64 + fr + ai * HALF + m * 16, row = u.pm * BM + rl; const float rsc = tab[rl];
                const f32x4 c = *(const f32x4*)(cs + (size_t)(row & 4095) * half + d0), s = *(const f32x4*)(sn + (size_t)(row & 4095) * half + d0);
                bf16_t* rowp = O + (size_t)row * ldc + gcol;
#pragma unroll
                for (int bj = 0; bj < 2; ++bj) { const f32x4 x1 = acc[ai][bj][m][0] * rsc, x2 = acc[ai][bj][m][1] * rsc;
                    const f32x4 y1 = x1 * c - x2 * s, y2 = x2 * c + x1 * s;
                    u32x2 w1, w2; w1.x = cvt_pk_bf16(y1[0], y1[1]); w1.y = cvt_pk_bf16(y1[2], y1[3]); w2.x = cvt_pk_bf16(y2[0], y2[1]); w2.y = cvt_pk_bf16(y2[2], y2[3]);
                    *(u32x2*)(rowp + bj * HALF) = w1; *(u32x2*)(rowp + bj * HALF + half) = w2; } }
    }
};
__device__ __forceinline__ float silu_mul(float g, float u) { return g * __builtin_amdgcn_rcpf(1.0f + __expf(-g)) * u; }
struct EpiSwiGLU {
    static constexpr bool PERM = true, AFTER_DRAIN = false;
    bf16_t* O; int ldc; const float* rs;
    __device__ __forceinline__ void operator()(const f32x4 (&acc)[2][2][4][2], const Unit& u, int wr, int wc, int fr, int fq) const {
        const int row0 = u.pm * BM + wr * 64 + fr; const int col0 = u.pn * HALF + wc * 32 + 8 * fq;
        stats_table(rs, u.pm * BM, (wr * 4 + wc) * 64 + fq * 16 + fr); const lds_f32* tab = stats_tab();
#pragma unroll
        for (int ai = 0; ai < 2; ++ai)
#pragma unroll
            for (int m = 0; m < 4; ++m) { const int row = row0 + ai * HALF + m * 16; bf16_t* rowp = O + (size_t)row * ldc + col0; const float rsc = tab[wr * 64 + fr + ai * HALF + m * 16];
                const f32x4 g0 = acc[ai][0][m][0] * rsc, g1 = acc[ai][0][m][1] * rsc, u0 = acc[ai][1][m][0] * rsc, u1 = acc[ai][1][m][1] * rsc;
                u32x4 w;
                w.x = cvt_pk_bf16(silu_mul(g0[0], u0[0]), silu_mul(g0[1], u0[1])); w.y = cvt_pk_bf16(silu_mul(g0[2], u0[2]), silu_mul(g0[3], u0[3]));
                w.z = cvt_pk_bf16(silu_mul(g1[0], u1[0]), silu_mul(g1[1], u1[1])); w.w = cvt_pk_bf16(silu_mul(g1[2], u1[2]), silu_mul(g1[3], u1[3]));
                *(u32x4*)(rowp) = w; }
    }
};
__device__ __forceinline__ void publish_row(const f32x4 (&xn)[2][2], bf16_t* xbrow, float* ssrow, int fq, int lane) {
    typedef unsigned u32x2 __attribute__((ext_vector_type(2)));
    float q = 0.f;
#pragma unroll
    for (int bj = 0; bj < 2; ++bj)
#pragma unroll
        for (int n = 0; n < 2; ++n) { const f32x4 v = xn[bj][n]; q += (v[0] * v[0] + v[1] * v[1]) + (v[2] * v[2] + v[3] * v[3]);
            u32x2 w; w.x = cvt_pk_bf16(v[0], v[1]); w.y = cvt_pk_bf16(v[2], v[3]); *(u32x2*)(xbrow + bj * HALF + n * 16) = w; }
    q += __int_as_float(__builtin_amdgcn_ds_bpermute((lane ^ 16) << 2, __float_as_int(q)));
    q += __int_as_float(__builtin_amdgcn_ds_bpermute((lane ^ 32) << 2, __float_as_int(q)));
    if (fq == 0) *ssrow = q;
}
constexpr int EPI_DP = 3;
struct EpiResidual {
    static constexpr bool PERM = false, AFTER_DRAIN = false;
    bf16_t* S; float* ss; int ldc; float alpha;
    __device__ __forceinline__ void operator()(const f32x4 (&acc)[2][2][4][2], const Unit& u, int wr, int wc, int fr, int fq) const {
        typedef unsigned u32x2 __attribute__((ext_vector_type(2)));
        const int row0 = u.pm * BM + wr * 64 + fr; const int col0 = u.pn * BM + wc * 32 + 4 * fq; const int lane = fq * 16 + fr;
        u32x2 xv[2][2], xnext[2][2];
#pragma unroll
        for (int bj = 0; bj < 2; ++bj)
#pragma unroll
            for (int n = 0; n < 2; ++n) xnext[bj][n] = *(const u32x2*)(S + (size_t)row0 * ldc + col0 + bj * HALF + n * 16);
#pragma unroll
        for (int r = 0; r < 8; ++r) { const int ai = r >> 2, m = r & 3; const int row = row0 + ai * HALF + m * 16;
#pragma unroll
            for (int bj = 0; bj < 2; ++bj)
#pragma unroll
                for (int n = 0; n < 2; ++n) xv[bj][n] = xnext[bj][n];
            if (r < 7) { const int rown = row0 + ((r + 1) >> 2) * HALF + ((r + 1) & 3) * 16;
#pragma unroll
                for (int bj = 0; bj < 2; ++bj)
#pragma unroll
                    for (int n = 0; n < 2; ++n) xnext[bj][n] = *(const u32x2*)(S + (size_t)rown * ldc + col0 + bj * HALF + n * 16); }
            f32x4 xn[2][2];
#pragma unroll
            for (int bj = 0; bj < 2; ++bj)
#pragma unroll
                for (int n = 0; n < 2; ++n) { const u32x2 w = xv[bj][n]; f32x4 xo; xo[0] = __uint_as_float(w.x << 16); xo[1] = __uint_as_float(w.x & 0xffff0000u); xo[2] = __uint_as_float(w.y << 16); xo[3] = __uint_as_float(w.y & 0xffff0000u);
                    xn[bj][n] = xo + acc[ai][bj][m][n] * alpha; }
            publish_row(xn, S + (size_t)row * ldc + col0, ss + (size_t)row * 32 + u.pn * 4 + wc, fq, lane); }
    }
};
struct EpiGate {
    static constexpr bool PERM = false, AFTER_DRAIN = false;
    const bf16_t* Sin; const bf16_t* T; bf16_t* Sout; float* ss; const float* rs; int ldc;
    __device__ __forceinline__ void operator()(const f32x4 (&acc)[2][2][4][2], const Unit& u, int wr, int wc, int fr, int fq) const {
        typedef unsigned u32x2 __attribute__((ext_vector_type(2)));
        const int row0 = u.pm * BM + wr * 64 + fr; const int col0 = u.pn * BM + wc * 32 + 4 * fq; const int lane = fq * 16 + fr;
        stats_table(rs, u.pm * BM, (wr * 4 + wc) * 64 + lane); const lds_f32* tab = stats_tab();
        u32x2 xv[2][2], xnext[2][2], tv[2][2], tnext[2][2];
#pragma unroll
        for (int bj = 0; bj < 2; ++bj)
#pragma unroll
            for (int n = 0; n < 2; ++n) { const size_t o_ = (size_t)row0 * ldc + col0 + bj * HALF + n * 16; xnext[bj][n] = *(const u32x2*)(Sin + o_); tnext[bj][n] = *(const u32x2*)(T + o_); }
#pragma unroll
        for (int r = 0; r < 8; ++r) { const int ai = r >> 2, m = r & 3; const int row = row0 + ai * HALF + m * 16; const size_t off = (size_t)row * ldc + col0; const float rsc = tab[wr * 64 + fr + ai * HALF + m * 16];
#pragma unroll
            for (int bj = 0; bj < 2; ++bj)
#pragma unroll
                for (int n = 0; n < 2; ++n) { xv[bj][n] = xnext[bj][n]; tv[bj][n] = tnext[bj][n]; }
            if (r < 7) { const int rown = row0 + ((r + 1) >> 2) * HALF + ((r + 1) & 3) * 16;
#pragma unroll
                for (int bj = 0; bj < 2; ++bj)
#pragma unroll
                    for (int n = 0; n < 2; ++n) { const size_t o_ = (size_t)rown * ldc + col0 + bj * HALF + n * 16; xnext[bj][n] = *(const u32x2*)(Sin + o_); tnext[bj][n] = *(const u32x2*)(T + o_); } }
            f32x4 xn[2][2];
#pragma unroll
            for (int bj = 0; bj < 2; ++bj)
#pragma unroll
                for (int n = 0; n < 2; ++n) { const f32x4 a = acc[ai][bj][m][n] * rsc; const u32x2 t2 = tv[bj][n], x2 = xv[bj][n];
                    f32x4 t, xo; t[0] = __uint_as_float(t2.x << 16); t[1] = __uint_as_float(t2.x & 0xffff0000u); t[2] = __uint_as_float(t2.y << 16); t[3] = __uint_as_float(t2.y & 0xffff0000u);
                    xo[0] = __uint_as_float(x2.x << 16); xo[1] = __uint_as_float(x2.x & 0xffff0000u); xo[2] = __uint_as_float(x2.y << 16); xo[3] = __uint_as_float(x2.y & 0xffff0000u);
                    f32x4 o;
#pragma unroll
                    for (int e_ = 0; e_ < 4; ++e_) o[e_] = xo[e_] + __builtin_amdgcn_rcpf(1.0f + __expf(-a[e_])) * t[e_];
                    xn[bj][n] = o; }
            publish_row(xn, Sout + off, ss + (size_t)row * 32 + u.pn * 4 + wc, fq, lane); }
    }
};
__device__ __forceinline__ int fresh_lane() { unsigned o_ = ~0u; asm volatile("" : "+s"(o_)); return (int)__builtin_amdgcn_mbcnt_hi(o_, __builtin_amdgcn_mbcnt_lo(o_, 0u)); }
template <class Epi, class Sched, bool ALIGN_EPI = false, bool SP2 = false>
__device__ __forceinline__ void gemm_phase(PG8_LAS unsigned char* lds, const Gemm g, const Sched& S, const Epi& E, const int wid) {
    const int lane = fresh_lane(), tid = wid * 64 + lane, wr = wid >> 2, wc = wid & 3;
    const int K = g.K, nt = K / BK;
    unsigned voffA[2], voffB[2];
#pragma unroll
    for (int i = 0; i < 2; ++i) { int R, C; stage_rc(tid * 16 + i * 8192, R, C); const int Rb = Epi::PERM ? ((R & ~31) + perm32(R & 31)) : R;
        voffA[i] = (unsigned)(R * K + C) * 2u; voffB[i] = (unsigned)(Rb * K + C) * 2u; }
    const size_t kstep = (size_t)(BK * 2);
    const size_t hstep = (size_t)HALF * K * 2;
    const size_t tstep = 2 * hstep;
    const unsigned ldsw = (unsigned)wid * 1024u;
    const int aoff = lds_byte(wr * 64 + (lane & 15), (lane >> 4) * 8), boff = lds_byte(wc * 32 + (lane & 15), (lane >> 4) * 8);
#define PG8_SA(b, h) (((b) * 2 + (h)) * HTB)
#define PG8_SB(b, h) ((4 + (b) * 2 + (h)) * HTB)
#define PG8_STAGE(bufoff, gbase, voff) do { _Pragma("unroll") for (int _i = 0; _i < 2; ++_i) \
        __builtin_amdgcn_global_load_lds((const unsigned*)((const char*)(gbase) + (voff)[_i]), (PG8_LAS unsigned*)(lds + (bufoff) + ldsw + _i * 8192), 16, 0, 0); } while (0)
#define PG8_LDA(dst, b, h) do { _Pragma("unroll") for (int m = 0; m < 4; ++m) _Pragma("unroll") for (int k = 0; k < 2; ++k) dst[m][k] = *(const PG8_LAS bf16x8*)(lds + PG8_SA(b, h) + aoff + m * 2048 + k * 1024); } while (0)
#define PG8_LDB(dst, b, h) do { _Pragma("unroll") for (int n = 0; n < 2; ++n) _Pragma("unroll") for (int k = 0; k < 2; ++k) dst[n][k] = *(const PG8_LAS bf16x8*)(lds + PG8_SB(b, h) + boff + n * 2048 + k * 1024); } while (0)
#define PG8_MMA(ai, bj, At, Bt) do { __builtin_amdgcn_s_setprio(1); _Pragma("unroll") for (int m = 0; m < 4; ++m) _Pragma("unroll") for (int n = 0; n < 2; ++n) _Pragma("unroll") for (int k = 0; k < 2; ++k) \
        acc[ai][bj][m][n] = __builtin_amdgcn_mfma_f32_16x16x32_bf16(Bt[n][k], At[m][k], acc[ai][bj][m][n], 0, 0, 0); __builtin_amdgcn_s_setprio(0); } while (0)
#define PG8_WAIT_V(n) asm volatile("s_waitcnt vmcnt(" #n ")" ::: "memory")
#define PG8_WAIT_L(n) asm volatile("s_waitcnt lgkmcnt(" #n ")" ::: "memory")
#define PG8_BAR __builtin_amdgcn_s_barrier()
#define PG8_SCHED __builtin_amdgcn_sched_barrier(0)
    Unit cur, nxt; int ui = 0;
    if (!S.next(0, cur)) return;
    f32x4 acc[2][2][4][2];
    float zf_ = 0.f; asm volatile("" : "+v"(zf_));
#pragma unroll
    for (int a = 0; a < 2; ++a)
#pragma unroll
        for (int b = 0; b < 2; ++b)
#pragma unroll
            for (int m = 0; m < 4; ++m)
#pragma unroll
                for (int n = 0; n < 2; ++n) acc[a][b][m][n] = (f32x4){zf_, zf_, zf_, zf_};
    bf16x8 At[4][2], B0[2][2], B1[2][2];
    const char* cA = (const char*)g.A + (size_t)cur.pm * tstep; const char* cB = (const char*)g.Bt + (size_t)cur.pn * tstep;
    S.a_ready(cur);
    if constexpr (SP2) {
        PG8_STAGE(PG8_SB(0, 0), cB, voffB); PG8_STAGE(PG8_SB(0, 1), cB + hstep, voffB); PG8_STAGE(PG8_SA(0, 0), cA, voffA); PG8_STAGE(PG8_SA(0, 1), cA + hstep, voffA);
        if (wr == 1) PG8_BAR;
        PG8_WAIT_V(2); PG8_BAR;
        PG8_STAGE(PG8_SB(1, 0), cB + kstep, voffB); PG8_STAGE(PG8_SA(1, 0), cA + kstep, voffA); PG8_STAGE(PG8_SB(1, 1), cB + hstep + kstep, voffB);
        PG8_WAIT_V(6); PG8_BAR;
    } else {
        PG8_STAGE(PG8_SB(0, 0), cB, voffB); PG8_STAGE(PG8_SA(0, 0), cA, voffA); PG8_STAGE(PG8_SB(0, 1), cB + hstep, voffB); PG8_STAGE(PG8_SA(0, 1), cA + hstep, voffA);
        if (wr == 1) PG8_BAR;
        PG8_WAIT_V(4); PG8_BAR;
        PG8_STAGE(PG8_SB(1, 0), cB + kstep, voffB); PG8_STAGE(PG8_SA(1, 0), cA + kstep, voffA); PG8_STAGE(PG8_SB(1, 1), cB + hstep + kstep, voffB);
        PG8_WAIT_V(6); PG8_BAR;
    }
    for (;;) {
        const bool has_next = S.next(ui + 1, nxt);
        const char* nA = has_next ? (const char*)g.A + (size_t)nxt.pm * tstep : cA; const char* nB = has_next ? (const char*)g.Bt + (size_t)nxt.pn * tstep : cB;
        for (int t = 0; t < nt; t += 2) {
            const bool last = (t == nt - 2);
            const char* a1 = cA + (size_t)(t + 1) * kstep;
            const char* a2 = last ? nA : cA + (size_t)(t + 2) * kstep; const char* b2 = last ? nB : cB + (size_t)(t + 2) * kstep;
            const char* a3 = a2 + kstep; const char* b3 = b2 + kstep;
            if (last && has_next) S.a_ready(nxt);
            if constexpr (SP2) {
            PG8_LDB(B0, 0, 0); PG8_LDB(B1, 0, 1); PG8_SCHED; PG8_LDA(At, 0, 0); PG8_STAGE(PG8_SA(1, 1), a1 + hstep, voffA);
            PG8_WAIT_V(8); PG8_WAIT_L(0); PG8_BAR; PG8_MMA(0, 0, At, B0); PG8_MMA(0, 1, At, B1); PG8_BAR; PG8_SCHED;
            PG8_LDA(At, 0, 1); PG8_STAGE(PG8_SB(0, 0), b2, voffB); PG8_STAGE(PG8_SB(0, 1), b2 + hstep, voffB); PG8_STAGE(PG8_SA(0, 0), a2, voffA);
            PG8_WAIT_V(8); PG8_WAIT_L(0); PG8_BAR; PG8_MMA(1, 0, At, B0); PG8_MMA(1, 1, At, B1); PG8_BAR; PG8_SCHED;
            PG8_LDB(B0, 1, 0); PG8_LDB(B1, 1, 1); PG8_SCHED; PG8_LDA(At, 1, 0); PG8_STAGE(PG8_SA(0, 1), a2 + hstep, voffA);
            PG8_WAIT_V(8); PG8_WAIT_L(0); PG8_BAR; PG8_MMA(0, 0, At, B0); PG8_MMA(0, 1, At, B1); PG8_BAR; PG8_SCHED;
            PG8_LDA(At, 1, 1); PG8_STAGE(PG8_SB(1, 0), b3, voffB); PG8_STAGE(PG8_SB(1, 1), b3 + hstep, voffB); PG8_STAGE(PG8_SA(1, 0), a3, voffA);
            PG8_WAIT_V(8); PG8_WAIT_L(0); PG8_BAR; PG8_MMA(1, 0, At, B0); PG8_MMA(1, 1, At, B1); PG8_BAR; PG8_SCHED;
            } else {
            PG8_LDB(B0, 0, 0); PG8_SCHED; PG8_LDA(At, 0, 0); PG8_STAGE(PG8_SA(1, 1), a1 + hstep, voffA);
            PG8_WAIT_L(8); PG8_BAR; PG8_WAIT_L(0); PG8_MMA(0, 0, At, B0); PG8_BAR; PG8_SCHED;
            PG8_LDB(B1, 0, 1); PG8_STAGE(PG8_SB(0, 0), b2, voffB);
            PG8_BAR; PG8_WAIT_L(0); PG8_MMA(0, 1, At, B1); PG8_BAR;
            PG8_LDA(At, 0, 1); PG8_STAGE(PG8_SA(0, 0), a2, voffA);
            PG8_BAR; PG8_WAIT_L(0); PG8_MMA(1, 0, At, B0); PG8_BAR; PG8_SCHED;
            PG8_STAGE(PG8_SB(0, 1), b2 + hstep, voffB);
            PG8_WAIT_V(6); PG8_BAR; PG8_MMA(1, 1, At, B1); PG8_BAR;
            PG8_LDB(B0, 1, 0); PG8_SCHED; PG8_LDA(At, 1, 0); PG8_STAGE(PG8_SA(0, 1), a2 + hstep, voffA);
            PG8_WAIT_L(8); PG8_BAR; PG8_WAIT_L(0); PG8_MMA(0, 0, At, B0); PG8_BAR; PG8_SCHED;
            PG8_LDB(B1, 1, 1); PG8_STAGE(PG8_SB(1, 0), b3, voffB);
            PG8_BAR; PG8_WAIT_L(0); PG8_MMA(0, 1, At, B1); PG8_BAR;
            PG8_LDA(At, 1, 1); PG8_STAGE(PG8_SA(1, 0), a3, voffA);
            PG8_BAR; PG8_WAIT_L(0); PG8_MMA(1, 0, At, B0); PG8_BAR; PG8_SCHED;
            PG8_STAGE(PG8_SB(1, 1), b3 + hstep, voffB);
            PG8_WAIT_V(6); PG8_BAR; PG8_MMA(1, 1, At, B1); PG8_BAR;
            }
        }
        if constexpr (ALIGN_EPI) { if (wr == 0) PG8_BAR; }
        if constexpr (!Epi::AFTER_DRAIN) { const int le_ = fresh_lane(); E(acc, cur, wr, wc, le_ & 15, le_ >> 4); S.done(cur); }
        if (!has_next) break;
#pragma unroll
        for (int a = 0; a < 2; ++a)
#pragma unroll
            for (int b = 0; b < 2; ++b)
#pragma unroll
                for (int m = 0; m < 4; ++m)
#pragma unroll
                    for (int n = 0; n < 2; ++n) acc[a][b][m][n] = (f32x4){zf_, zf_, zf_, zf_};
        cur = nxt; cA = nA; cB = nB; ++ui;
        if constexpr (ALIGN_EPI) { if (wr == 1) PG8_BAR; }
    }
    PG8_WAIT_V(0);
    if constexpr (!ALIGN_EPI) { if (wr == 0) PG8_BAR; }
    PG8_BAR;
    if constexpr (Epi::AFTER_DRAIN) { const int le_ = fresh_lane(); E.fused(acc, cur, wr, wc, le_ & 15, le_ >> 4, lds, wid, le_); S.done(cur); }
#undef PG8_SA
#undef PG8_SB
#undef PG8_STAGE
#undef PG8_LDA
#undef PG8_LDB
#undef PG8_MMA
#undef PG8_WAIT_V
#undef PG8_WAIT_L
#undef PG8_BAR
#undef PG8_SCHED
}
}
#define GAS __attribute__((address_space(1)))
#define LAS __attribute__((address_space(3)))
typedef unsigned short bf16;
typedef unsigned v4u __attribute__((ext_vector_type(4)));
typedef unsigned v2u __attribute__((ext_vector_type(2)));
typedef float f32x4 __attribute__((ext_vector_type(4)));
#define LDS_WAIT() asm volatile("s_waitcnt lgkmcnt(0)" ::: "memory")

constexpr int NWAVES = 8;
constexpr int SEQ = 4096, NB = 4, M = NB * SEQ, D = 2048, DFF = 5632, PLE = 256;
constexpr int AB_IN = 7680, AB_OUT = 1536, CD_IN = 3904, CD_INP = 4160, CD_OUT = 2048;
constexpr int KV_LD = 1088, VTP = M + 64;
constexpr float EPS = 1e-6f;
constexpr size_t MiB = 1u << 20;
constexpr size_t WS_ROPE = 1 * MiB, WS_KMEAN = 4 * MiB;
constexpr size_t WS_WGU = 8 * MiB, WGU_SZ = 44 * MiB, WS_WDN = 184 * MiB, WDN_SZ = 22 * MiB;
constexpr size_t WS_WABIN = 272 * MiB, WS_WABOUT = 302 * MiB, WS_WCDIN = 308 * MiB, WS_WUQ = 324 * MiB, WS_WUKV = 326 * MiB, WS_WCDOUT = 328 * MiB;
constexpr size_t WS_WGATE = 336 * MiB, WGATE_SZ = 8 * MiB, WS_WPROJ = 352 * MiB, WPROJ_SZ = 1 * MiB;
constexpr size_t WS_PB = 354 * MiB, WS_H = 370 * MiB, WS_ACT = 434 * MiB, WS_Z = 610 * MiB, WS_O = 850 * MiB, WS_T = 914 * MiB;
constexpr size_t WS_QC = 978 * MiB, WS_KV = 1026 * MiB, WS_CQN = 1090 * MiB, WS_CKVN = 1106 * MiB;
constexpr size_t WS_VTA = 1114 * MiB, WS_VTB = 1148 * MiB, WS_VTC = 1198 * MiB, WS_VTD = 1232 * MiB, WS_HB = 1266 * MiB, WS_END = 1350 * MiB;
constexpr size_t WS_SS = 1330 * MiB, SS_SITE = (size_t)M * 32;
constexpr int LDS_BYTES = 147456;

__device__ __forceinline__ unsigned f2bf(float f) { unsigned u = __builtin_bit_cast(unsigned, f); return (u + 0x7fffu + ((u >> 16) & 1u)) >> 16; }
__device__ __forceinline__ unsigned pk2(float lo, float hi) { return f2bf(lo) | (f2bf(hi) << 16); }
__device__ __forceinline__ float bflo(unsigned w) { return __uint_as_float(w << 16); }
__device__ __forceinline__ float bfhi(unsigned w) { return __uint_as_float(w & 0xffff0000u); }
__device__ __forceinline__ float shfl_xor_l(float v, int mask, int lane) { return __int_as_float(__builtin_amdgcn_ds_bpermute((lane ^ mask) << 2, __float_as_int(v))); }
__device__ __forceinline__ float wave_sum(float v, int lane) {
#pragma unroll
    for (int o = 1; o < 64; o <<= 1) v += shfl_xor_l(v, o, lane);
    return v;
}
__device__ __forceinline__ float wave_max(float v, int lane) {
#pragma unroll
    for (int o = 1; o < 64; o <<= 1) v = fmaxf(v, shfl_xor_l(v, o, lane));
    return v;
}
__device__ __forceinline__ void half_pair(float v, float& lo, float& hi) { auto rr = __builtin_amdgcn_permlane32_swap(__float_as_uint(v), __float_as_uint(v), false, false); lo = __uint_as_float(rr[0]); hi = __uint_as_float(rr[1]); }
__device__ __forceinline__ float half_sum(float v) { float a, b; half_pair(v, a, b); return a + b; }
__device__ __forceinline__ float half_max(float v) { float a, b; half_pair(v, a, b); return fmaxf(a, b); }

__device__ __forceinline__ int rope_row128(int d) { return 32 * ((d & 63) >> 4) + 8 * (((d & 63) >> 2) & 3) + 4 * (d >> 6) + (d & 3); }
__device__ __forceinline__ int rope_row64(int d) { return 32 * ((d & 31) >> 4) + 8 * (((d & 31) >> 2) & 3) + 4 * (d >> 5) + (d & 3); }
__device__ __forceinline__ void transpose_item(const float* W, int K, int N, bf16* WT, int k0, int n0, int drow0, LAS float* scr, int lane, const float* gain, int rmode = 0) {
    const int c = lane & 7;
    f32x4 g0 = {1.f, 1.f, 1.f, 1.f}, g1 = {1.f, 1.f, 1.f, 1.f};
    if (gain) { g0 = *(const f32x4*)(gain + k0 + 8 * c); g1 = *(const f32x4*)(gain + k0 + 8 * c + 4); }
    float wv[32];
#pragma unroll
    for (int i = 0; i < 32; ++i) { const int kk = 2 * i + (lane >> 5); wv[i] = W[(size_t)(k0 + kk) * N + n0 + (lane & 31)]; }
#pragma unroll
    for (int i = 0; i < 32; ++i) { const int kk = 2 * i + (lane >> 5); scr[kk * 33 + (lane & 31)] = wv[i]; }
    LDS_WAIT(); asm volatile("" ::: "memory");
#pragma unroll
    for (int j = 0; j < 4; ++j) { const int n = (lane >> 3) + 8 * j; const LAS float* s = scr + (8 * c) * 33 + n;
        v4u o; o.x = pk2(s[0 * 33] * g0.x, s[1 * 33] * g0.y); o.y = pk2(s[2 * 33] * g0.z, s[3 * 33] * g0.w); o.z = pk2(s[4 * 33] * g1.x, s[5 * 33] * g1.y); o.w = pk2(s[6 * 33] * g1.z, s[7 * 33] * g1.w);
        const int ng = n0 + n; const int drow = (rmode == 1) ? (ng & ~127) + rope_row128(ng & 127) : (rmode == 2) ? (ng & ~63) + rope_row64(ng & 63) : drow0 + n;
        *(v4u*)(WT + (size_t)drow * K + k0 + 8 * c) = o; }
    LDS_WAIT(); asm volatile("" ::: "memory");
}
__device__ __forceinline__ void conv_matrix(const float* W, int K, int N, bf16* WT, int mode, LAS float* scr, int lane, int gw, int ngw, const float* gain = nullptr) {
    const int nblk = N / 32, items = (K / 64) * nblk;
    for (int it = gw; it < items; it += ngw) {
        const int kb = it / nblk, nb = it % nblk, n0 = 32 * nb; int drow0 = n0;
        if (mode == 1) { const int f = (n0 < DFF) ? n0 : n0 - DFF; drow0 = 256 * (f >> 7) + (f & 127) + ((n0 < DFF) ? 0 : 128); }
        if (mode == 2) { const int hd = n0 >> 8, t = n0 & 255; drow0 = (t < 128) ? hd * 128 + t : 1024 + hd * 128 + (t - 128); }
        int rmode = 0; if (mode == 3) rmode = (n0 < 2048) ? 2 : (n0 >= 3072 && n0 < 6144) ? 1 : 0;
        transpose_item(W, K, N, WT, 64 * kb, n0, drow0, scr, lane, gain, rmode);
    }
}
__device__ __forceinline__ void first_row(const float* xrow, bf16* xb, float* ss, int lane) {
    const f32x4* xr = (const f32x4*)xrow + lane; v2u* o8 = (v2u*)xb + lane;
    f32x4 v[8]; float s = 0.f;
#pragma unroll
    for (int j = 0; j < 8; ++j) { v[j] = xr[64 * j]; s += (v[j].x * v[j].x + v[j].y * v[j].y) + (v[j].z * v[j].z + v[j].w * v[j].w); }
#pragma unroll
    for (int j = 0; j < 8; ++j) { v2u w; w.x = pk2(v[j].x, v[j].y); w.y = pk2(v[j].z, v[j].w); o8[64 * j] = w; }
    s = wave_sum(s, lane);
    if (lane < 32) ss[lane] = (lane == 0) ? s : 0.f;
}
__device__ __forceinline__ void final_norm_row(const bf16* srow, float* orow, const float* gain, float ssv, int lane) {
    const v2u* sr = (const v2u*)srow + lane; f32x4* xr = (f32x4*)orow + lane; const f32x4* gr = (const f32x4*)gain + lane;
    const float rstd = rsqrtf(ssv * (1.f / D) + EPS);
    v2u w[8];
#pragma unroll
    for (int j = 0; j < 8; ++j) w[j] = sr[64 * j];
#pragma unroll
    for (int j = 0; j < 8; ++j) { const f32x4 g = gr[64 * j]; xr[64 * j] = (f32x4){bflo(w[j].x) * rstd * g.x, bfhi(w[j].x) * rstd * g.y, bflo(w[j].y) * rstd * g.z, bfhi(w[j].y) * rstd * g.w}; }
}
__device__ __forceinline__ void rope8(bf16* p, int half, const float* cs, const float* sn) {
    const v4u a = *(const v4u*)p, b = *(const v4u*)(p + half);
    const f32x4 c0 = *(const f32x4*)cs, c1 = *(const f32x4*)(cs + 4), s0 = *(const f32x4*)sn, s1 = *(const f32x4*)(sn + 4);
    float x1[8] = {bflo(a.x), bfhi(a.x), bflo(a.y), bfhi(a.y), bflo(a.z), bfhi(a.z), bflo(a.w), bfhi(a.w)};
    float x2[8] = {bflo(b.x), bfhi(b.x), bflo(b.y), bfhi(b.y), bflo(b.z), bfhi(b.z), bflo(b.w), bfhi(b.w)};
    float c[8] = {c0.x, c0.y, c0.z, c0.w, c1.x, c1.y, c1.z, c1.w}, s[8] = {s0.x, s0.y, s0.z, s0.w, s1.x, s1.y, s1.z, s1.w};
    float y1[8], y2[8];
#pragma unroll
    for (int e = 0; e < 8; ++e) { y1[e] = x1[e] * c[e] - x2[e] * s[e]; y2[e] = x2[e] * c[e] + x1[e] * s[e]; }
    v4u oa, ob;
    oa.x = pk2(y1[0], y1[1]); oa.y = pk2(y1[2], y1[3]); oa.z = pk2(y1[4], y1[5]); oa.w = pk2(y1[6], y1[7]);
    ob.x = pk2(y2[0], y2[1]); ob.y = pk2(y2[2], y2[3]); ob.z = pk2(y2[4], y2[5]); ob.w = pk2(y2[6], y2[7]);
    *(v4u*)p = oa; *(v4u*)(p + half) = ob;
}
__device__ __forceinline__ void small_norm(const bf16* src, int n, const float* gain, bf16* dst, int lane) {
    float s = 0.f; v2u w[2];
    const int nch = n / 256;
#pragma unroll
    for (int j = 0; j < 2; ++j) if (j < nch) { w[j] = *(const v2u*)(src + 4 * (lane + 64 * j)); const float a = bflo(w[j].x), b = bfhi(w[j].x), c = bflo(w[j].y), d = bfhi(w[j].y); s += (a * a + b * b) + (c * c + d * d); }
    const float rstd = rsqrtf(wave_sum(s, lane) / (float)n + EPS);
#pragma unroll
    for (int j = 0; j < 2; ++j) if (j < nch) { const f32x4 g = *(const f32x4*)(gain + 4 * (lane + 64 * j)); v2u o;
        o.x = pk2(bflo(w[j].x) * rstd * g.x, bfhi(w[j].x) * rstd * g.y); o.y = pk2(bflo(w[j].y) * rstd * g.z, bfhi(w[j].y) * rstd * g.w);
        *(v2u*)(dst + 4 * (lane + 64 * j)) = o; }
}

#define XB_TMO      128
#define XB_XCNT(j)  (256  + 64 * (j))
#define XB_XSUB(j)  (1280 + 64 * (j))
#define XB_XGEN(j)  (2304 + 64 * (j))
#define XB_TOP      3328
#define XB_TOPGEN   3392
#define XCD_BAR_WORDS 3456
#define XB_SPIN_CAP (1u << 18)

__device__ __forceinline__ unsigned xb_ld(unsigned* p)              { return __hip_atomic_load(p, __ATOMIC_RELAXED, __HIP_MEMORY_SCOPE_AGENT); }
__device__ __forceinline__ unsigned xb_add(unsigned* p, unsigned v) { return __hip_atomic_fetch_add(p, v, __ATOMIC_RELAXED, __HIP_MEMORY_SCOPE_AGENT); }
__device__ __forceinline__ unsigned xb_xcc_id() { return (unsigned)__builtin_amdgcn_s_getreg((3 << 11) | 20) & 0xFu; }
#define XB_SPIN(cond, bar) do { unsigned _sp = 0; while (cond) { __builtin_amdgcn_s_sleep(1); \
    if ((++_sp & 255u) == 0u) { if (xb_ld(&(bar)[XB_TMO])) break; if (_sp > XB_SPIN_CAP) { atomicAdd(&(bar)[XB_TMO], 1u); break; } } } } while (0)

struct XcdBarrier {
    unsigned* bar; unsigned x;
    volatile LAS unsigned* st;
};

__device__ __forceinline__ XcdBarrier xcd_barrier_post(unsigned* bar, volatile LAS unsigned* st) {
    XcdBarrier b; b.bar = bar; b.x = xb_xcc_id(); b.st = st;
    if (threadIdx.x == 0) (void)xb_add(&bar[XB_XCNT(b.x)], 1u);
    return b;
}
__device__ __forceinline__ void xcd_barrier_complete(unsigned* bar, unsigned x, unsigned& nloc, unsigned& nx) {
    const unsigned G = gridDim.x * gridDim.y * gridDim.z;
    unsigned sum, cnt, mine, sp = 0u;
    for (;;) {
        sum = 0u; cnt = 0u; mine = 0u;
#pragma unroll
        for (unsigned j = 0; j < 16; ++j) { const unsigned c = xb_ld(&bar[XB_XCNT(j)]); sum += c; cnt += (c > 0u) ? 1u : 0u; mine = (j == x) ? c : mine; }
        if (sum == G) break;
        __builtin_amdgcn_s_sleep(1);
        if ((++sp & 255u) == 0u) { if (xb_ld(&bar[XB_TMO])) break; if (sp > XB_SPIN_CAP) { atomicAdd(&bar[XB_TMO], 1u); break; } }
    }
    nloc = mine > 0u ? mine : 1u; nx = cnt > 0u ? cnt : 1u;
}

__device__ __forceinline__ void xcd_barrier(const XcdBarrier& b) {
    asm volatile("s_waitcnt vmcnt(0)" ::: "memory");
    __syncthreads();
    if (threadIdx.x == 0) {
        unsigned* bar = b.bar;
        __builtin_amdgcn_s_waitcnt(0);
        unsigned nloc = b.st[0], nx = b.st[1];
        if (nloc == 0u) { xcd_barrier_complete(bar, b.x, nloc, nx); b.st[0] = nloc; b.st[1] = nx; }
        const unsigned old = xb_add(&bar[XB_XSUB(b.x)], 1u);
        const unsigned gen = old / nloc;
        if (old + 1u == (gen + 1u) * nloc) {
            __builtin_amdgcn_fence(__ATOMIC_RELEASE, "agent");
            asm volatile("s_waitcnt vmcnt(0)" ::: "memory");
            const unsigned og = xb_add(&bar[XB_TOP], 1u);
            const unsigned tg = og / nx;
            if (og + 1u == (tg + 1u) * nx) xb_add(&bar[XB_TOPGEN], 1u);
            else XB_SPIN(xb_ld(&bar[XB_TOPGEN]) == tg, bar);
            __builtin_amdgcn_fence(__ATOMIC_ACQUIRE, "agent");
            xb_add(&bar[XB_XGEN(b.x)], 1u);
            asm volatile("s_waitcnt vmcnt(0)" ::: "memory");
        } else {
            XB_SPIN(xb_ld(&bar[XB_XGEN(b.x)]) == gen, bar);
            __builtin_amdgcn_fence(__ATOMIC_ACQUIRE, "agent");
            asm volatile("s_waitcnt vmcnt(0)" ::: "memory");
        }
    }
    __syncthreads();
}

typedef short bf16x8 __attribute__((ext_vector_type(8)));
typedef float f32x16 __attribute__((ext_vector_type(16)));
#define MFMA32(a, b, c) __builtin_amdgcn_mfma_f32_32x32x16_bf16((a), (b), (c), 0, 0, 0)
__device__ __forceinline__ int crow(int i, int hi) { return (i & 3) + 8 * (i >> 2) + 4 * hi; }
__device__ __forceinline__ unsigned cvtpk(float lo, float hi) { typedef float f2_t __attribute__((ext_vector_type(2))); typedef __bf16 b2_t __attribute__((ext_vector_type(2)));
    f2_t v = {lo, hi}; b2_t b = __builtin_convertvector(v, b2_t); return __builtin_bit_cast(unsigned, b); }

struct CtlCausal { static constexpr bool PAIR = true; int qw, r32, hi; bool moba; int own; unsigned selmask;
    __device__ __forceinline__ bool need(int kv0) const {
        if (kv0 > qw) return false;
        if (!moba) return true;
        const int blk = kv0 >> 8; if (blk == own) return true;
        return __ballot(((selmask >> blk) & 1u) != 0u) != 0ull; }
    __device__ __forceinline__ void range(int kvS, int& lo, int& shi) const { lo = 0; int nn = ((qw - kvS) >> 5) + 1; nn = nn < 0 ? 0 : (nn > 4 ? 4 : nn);
        if (moba) { const int blk = kvS >> 8; if (blk != own && __ballot(((selmask >> blk) & 1u) != 0u) == 0ull) nn = 0; }
        shi = nn; }
    __device__ __forceinline__ void mask(f32x16& s, int kv0) const {
        if (kv0 == qw) {
#pragma unroll
            for (int i = 0; i < 16; ++i) if (crow(i, hi) > r32) s[i] = -INFINITY; }
        if (moba) { const int blk = kv0 >> 8; const bool keep = (blk == own) || (((selmask >> blk) & 1u) != 0u);
#pragma unroll
            for (int i = 0; i < 16; ++i) s[i] = keep ? s[i] : -INFINITY; } } };
struct CtlDil { static constexpr bool PAIR = false; int qw, r32, hi, window, dilm1;
    __device__ __forceinline__ bool need(int kv0) const { return (kv0 + 31 >= qw - window) && (kv0 <= qw + 31); }
    __device__ __forceinline__ void range(int kvS, int& lo, int& shi) const {
        const int t = qw - window - 31 - kvS, u = qw + 31 - kvS;
        lo = t <= 0 ? 0 : ((t + 31) >> 5); lo = lo > 4 ? 4 : lo;
        shi = u < 0 ? 0 : ((u >> 5) + 1); shi = shi > 4 ? 4 : shi; }
    __device__ __forceinline__ void mask(f32x16& s, int kv0) const {
        const int d0 = (qw + r32) - kv0 - 4 * hi;
#pragma unroll
        for (int i = 0; i < 16; ++i) { const int dlt = d0 - ((i & 3) + 8 * (i >> 2)); const bool ok = (dlt >= 0) && (dlt <= window) && ((dlt & dilm1) == 0); s[i] = ok ? s[i] : -INFINITY; } } };

__device__ __forceinline__ void att_softmax(f32x16& s, float sc, float& m, float& l, f32x16 (&o)[4], bf16x8& pf0, bf16x8& pf1) {
    float mx = fmaxf(fmaxf(s[0], s[1]), fmaxf(s[2], s[3]));
#pragma unroll
    for (int i = 4; i < 16; i += 4) mx = fmaxf(mx, fmaxf(fmaxf(s[i], s[i + 1]), fmaxf(s[i + 2], s[i + 3])));
    mx = half_max(mx);
    const float mnew = fmaxf(m, mx * sc);
    const float msafe = (mnew == -INFINITY) ? 0.f : mnew;
    const float alpha = __builtin_amdgcn_exp2f(m - msafe);
    m = mnew;
    float rs0 = 0.f, rs1 = 0.f;
#pragma unroll
    for (int i = 0; i < 16; i += 2) { s[i] = __builtin_amdgcn_exp2f(s[i] * sc - msafe); s[i + 1] = __builtin_amdgcn_exp2f(s[i + 1] * sc - msafe); rs0 += s[i]; rs1 += s[i + 1]; }
    l = l * alpha + (rs0 + rs1);
    if (__builtin_amdgcn_ballot_w64(alpha != 1.0f) != 0ull) {
#pragma unroll
        for (int db = 0; db < 4; ++db) o[db] = o[db] * alpha; }
    v4u pw0, pw1;
    pw0.x = cvtpk(s[0], s[1]); pw0.y = cvtpk(s[2], s[3]); pw0.z = cvtpk(s[4], s[5]); pw0.w = cvtpk(s[6], s[7]);
    pw1.x = cvtpk(s[8], s[9]); pw1.y = cvtpk(s[10], s[11]); pw1.z = cvtpk(s[12], s[13]); pw1.w = cvtpk(s[14], s[15]);
    pf0 = __builtin_bit_cast(bf16x8, pw0); pf1 = __builtin_bit_cast(bf16x8, pw1);
}
__device__ __forceinline__ void att_pv(f32x16 (&o)[4], const LAS unsigned char* vb, bf16x8 pf0, bf16x8 pf1) {
#pragma unroll
    for (int s_ = 0; s_ < 2; ++s_)
#pragma unroll
        for (int db = 0; db < 4; ++db) {
            const LAS v2u* p0 = (const LAS v2u*)(vb + db * 32 * 136 + s_ * 32);
            const v2u al = p0[0], ah = p0[2];
            const v4u av = {al.x, al.y, ah.x, ah.y};
            o[db] = MFMA32(__builtin_bit_cast(bf16x8, av), s_ ? pf1 : pf0, o[db]);
        }
}
template <int NC1, int NC2> struct AttnGeom { static constexpr int NC = NC1 + NC2, CPR = 2 * NC, KSTRIDE = CPR * 16 + 16, KBYTES = 64 * KSTRIDE, VSTRIDE = 136, VBYTES = 128 * VSTRIDE, BUF = KBYTES + VBYTES, KCH = CPR / 8; };
template <int NC1, int NC2, class Ctl>
__device__ __forceinline__ void wg_attention(LAS unsigned char* lds, const bf16* k1, int ldk1, const bf16* k2, int ldk2, const bf16* vt, int tok0, int kvpos0, int nstages,
        const bf16x8 (&qf)[NC1 + NC2], float sc, const Ctl& ctl, f32x16 (&o)[4], float& m, float& l, int tid, int r32, int hi) {
    typedef AttnGeom<NC1, NC2> Gm; constexpr int NC = Gm::NC, CPR = Gm::CPR, KCH = Gm::KCH;
    v4u kreg[KCH], vreg[2];
#define WGA_LOAD(tok) do {   \
        const char* kb1_ = (const char*)(k1 + (size_t)(tok) * ldk1); const char* kb2_ = (NC2 > 0) ? (const char*)(k2 + (size_t)(tok) * ldk2) : kb1_; const char* vb_ = (const char*)(vt + (tok)); \
        _Pragma("unroll") for (int i_ = 0; i_ < KCH; ++i_) { const int id_ = tid + 512 * i_, row_ = id_ / CPR, c_ = id_ % CPR; \
            if (NC2 == 0 || c_ < 2 * NC1) kreg[i_] = *(const v4u*)(kb1_ + (size_t)(unsigned)((row_ * ldk1 + c_ * 8) * 2)); \
            else kreg[i_] = *(const v4u*)(kb2_ + (size_t)(unsigned)((row_ * ldk2 + (c_ - 2 * NC1) * 8) * 2)); } \
        _Pragma("unroll") for (int i_ = 0; i_ < 2; ++i_) { const int id_ = tid + 512 * i_, row_ = id_ >> 3, c_ = id_ & 7; vreg[i_] = *(const v4u*)(vb_ + (size_t)(unsigned)((row_ * VTP + c_ * 8) * 2)); } } while (0)
#define WGA_WRITE(buf) do { \
        _Pragma("unroll") for (int i_ = 0; i_ < KCH; ++i_) { const int id_ = tid + 512 * i_, row_ = id_ / CPR, c_ = id_ % CPR; *(LAS v4u*)(lds + (buf) * Gm::BUF + row_ * Gm::KSTRIDE + c_ * 16) = kreg[i_]; } \
        _Pragma("unroll") for (int i_ = 0; i_ < 2; ++i_) { const int id_ = tid + 512 * i_, row_ = id_ >> 3, c_ = id_ & 7; LAS v2u* d_ = (LAS v2u*)(lds + (buf) * Gm::BUF + Gm::KBYTES + row_ * Gm::VSTRIDE + c_ * 16); \
            d_[0] = (v2u){vreg[i_].x, vreg[i_].y}; d_[1] = (v2u){vreg[i_].z, vreg[i_].w}; } } while (0)
    WGA_LOAD(tok0); WGA_WRITE(0);
    __syncthreads();
#pragma unroll 1
    for (int j = 0; j < nstages; ++j) {
        const int buf = j & 1;
        if (j + 1 < nstages) WGA_LOAD(tok0 + 64 * (j + 1));
        const int kvA = kvpos0 + 64 * j, kvB = kvA + 32;
        const bool nA = ctl.need(kvA), nB = ctl.need(kvB);
        const LAS unsigned char* kbase = lds + buf * Gm::BUF + r32 * Gm::KSTRIDE + hi * 16;
        const LAS unsigned char* vbase = lds + buf * Gm::BUF + Gm::KBYTES + r32 * Gm::VSTRIDE + 8 * hi;
        constexpr bool KPRE = (NC <= 8);
        bf16x8 kf[NC];
        if (nA || nB) {
            const int first = nA ? 0 : 1;
#pragma unroll
            for (int c = 0; c < NC; ++c) kf[c] = *(const LAS bf16x8*)(kbase + first * 32 * Gm::KSTRIDE + c * 32);
#pragma unroll
            for (int sb = 0; sb < 2; ++sb) {
                if (!(sb ? nB : nA)) continue;
                if (!KPRE && sb == 1 && nA) {
#pragma unroll
                    for (int c = 0; c < NC; ++c) kf[c] = *(const LAS bf16x8*)(kbase + 32 * Gm::KSTRIDE + c * 32); }
                f32x16 s;
#pragma unroll
                for (int i = 0; i < 16; ++i) s[i] = 0.f;
#pragma unroll
                for (int c = 0; c < NC; ++c) s = MFMA32(kf[c], qf[c], s);
                __builtin_amdgcn_sched_barrier(0);
                v4u av[8];
#pragma unroll
                for (int s_ = 0; s_ < 2; ++s_)
#pragma unroll
                    for (int db = 0; db < 4; ++db) { const LAS v2u* p0 = (const LAS v2u*)(vbase + sb * 64 + db * 32 * 136 + s_ * 32); const v2u al = p0[0], ah = p0[2]; av[s_ * 4 + db] = (v4u){al.x, al.y, ah.x, ah.y}; }
                if (KPRE && sb == 0 && nB) {
#pragma unroll
                    for (int c = 0; c < NC; ++c) kf[c] = *(const LAS bf16x8*)(kbase + 32 * Gm::KSTRIDE + c * 32); }
                __builtin_amdgcn_sched_barrier(0);
                bf16x8 pa0, pa1;
                ctl.mask(s, sb ? kvB : kvA); att_softmax(s, sc, m, l, o, pa0, pa1);
                __builtin_amdgcn_sched_barrier(0);
#pragma unroll
                for (int s_ = 0; s_ < 2; ++s_)
#pragma unroll
                    for (int db = 0; db < 4; ++db) o[db] = MFMA32(__builtin_bit_cast(bf16x8, av[s_ * 4 + db]), s_ ? pa1 : pa0, o[db]);
                __builtin_amdgcn_sched_barrier(0);
            }
        }
        if (j + 1 < nstages) WGA_WRITE(buf ^ 1);
        __syncthreads();
    }
#undef WGA_LOAD
#undef WGA_WRITE
}
template <int NC, class Ctl>
__device__ __forceinline__ void wg_attention128(LAS unsigned char* lds, const bf16* k1, int ldk1, const bf16* vt, int tok0, int kvpos0, int nstages,
        const bf16x8 (&qf)[NC], float sc, const Ctl& ctl, f32x16 (&o)[4], float& m, float& l, int tid, int r32, int hi) {
    constexpr int CPR = 2 * NC, SK = 128, KSTRIDE = CPR * 16 + 16, KBYTES = SK * KSTRIDE, VSTRIDE = SK * 2 + 8, VBYTES = 128 * VSTRIDE, BUF = KBYTES + VBYTES, KCH = CPR * SK / 512, VCPR = SK / 8, VCH = 128 * VCPR / 512;
    static_assert(2 * BUF <= 143360 - 2048, "two stages must fit below the barrier / stats words at the top of LDS");
    v4u kreg[KCH], vreg[VCH];
#define WGB_LOAD(tok) do { const char* kb1_ = (const char*)(k1 + (size_t)(tok) * ldk1); const char* vb_ = (const char*)(vt + (tok)); \
        _Pragma("unroll") for (int i_ = 0; i_ < KCH; ++i_) { const int id_ = tid + 512 * i_, row_ = id_ / CPR, c_ = id_ % CPR; kreg[i_] = *(const v4u*)(kb1_ + (size_t)(unsigned)((row_ * ldk1 + c_ * 8) * 2)); } \
        _Pragma("unroll") for (int i_ = 0; i_ < VCH; ++i_) { const int id_ = tid + 512 * i_, row_ = id_ / VCPR, c_ = id_ % VCPR; vreg[i_] = *(const v4u*)(vb_ + (size_t)(unsigned)((row_ * VTP + c_ * 8) * 2)); } } while (0)
#define WGB_WRITE(buf) do { \
        _Pragma("unroll") for (int i_ = 0; i_ < KCH; ++i_) { const int id_ = tid + 512 * i_, row_ = id_ / CPR, c_ = id_ % CPR; *(LAS v4u*)(lds + (buf) * BUF + row_ * KSTRIDE + c_ * 16) = kreg[i_]; } \
        _Pragma("unroll") for (int i_ = 0; i_ < VCH; ++i_) { const int id_ = tid + 512 * i_, row_ = id_ / VCPR, c_ = id_ % VCPR; LAS v2u* d_ = (LAS v2u*)(lds + (buf) * BUF + KBYTES + row_ * VSTRIDE + c_ * 16); \
            d_[0] = (v2u){vreg[i_].x, vreg[i_].y}; d_[1] = (v2u){vreg[i_].z, vreg[i_].w}; } } while (0)
#pragma unroll
    for (int c = 0; c < NC; ++c) asm volatile("" :: "v"(qf[c]));
    WGB_LOAD(tok0); WGB_WRITE(0);
    __syncthreads();
#pragma unroll 1
    for (int j = 0; j < nstages; ++j) {
        const int buf = j & 1;
        if (j + 1 < nstages) WGB_LOAD(tok0 + SK * (j + 1));
        const int kvS = kvpos0 + SK * j;
        int lo, shi; ctl.range(kvS, lo, shi);
        const LAS unsigned char* kbase = lds + buf * BUF + r32 * KSTRIDE + hi * 16;
        const LAS unsigned char* vbase = lds + buf * BUF + KBYTES + r32 * VSTRIDE + 8 * hi;
        constexpr bool KPRE = (NC <= 4);
        bf16x8 kf[NC];
        if (KPRE && lo < shi) {
#pragma unroll
            for (int c = 0; c < NC; ++c) kf[c] = *(const LAS bf16x8*)(kbase + lo * 32 * KSTRIDE + c * 32);
        }
#pragma unroll 1
        for (int sb = lo; sb < shi; ++sb) {
            if (!KPRE) {
#pragma unroll
                for (int c = 0; c < NC; ++c) kf[c] = *(const LAS bf16x8*)(kbase + sb * 32 * KSTRIDE + c * 32); }
            f32x16 s;
#pragma unroll
            for (int i = 0; i < 16; ++i) s[i] = 0.f;
#pragma unroll
            for (int c = 0; c < NC; ++c) s = MFMA32(kf[c], qf[c], s);
            __builtin_amdgcn_sched_barrier(0);
            v4u av[8];
#pragma unroll
            for (int s_ = 0; s_ < 2; ++s_)
#pragma unroll
                for (int db = 0; db < 4; ++db) { const LAS v2u* p0 = (const LAS v2u*)(vbase + sb * 64 + db * 32 * VSTRIDE + s_ * 32); const v2u al = p0[0], ah = p0[2]; av[s_ * 4 + db] = (v4u){al.x, al.y, ah.x, ah.y}; }
            if (KPRE) { const int sn_ = (sb + 1 < shi) ? sb + 1 : sb;
#pragma unroll
              for (int c = 0; c < NC; ++c) kf[c] = *(const LAS bf16x8*)(kbase + sn_ * 32 * KSTRIDE + c * 32); }
            __builtin_amdgcn_sched_barrier(0);
            bf16x8 pa0, pa1;
            ctl.mask(s, kvS + 32 * sb); att_softmax(s, sc, m, l, o, pa0, pa1);
            __builtin_amdgcn_sched_barrier(0);
#pragma unroll
            for (int s_ = 0; s_ < 2; ++s_)
#pragma unroll
                for (int db = 0; db < 4; ++db) o[db] = MFMA32(__builtin_bit_cast(bf16x8, av[s_ * 4 + db]), s_ ? pa1 : pa0, o[db]);
            __builtin_amdgcn_sched_barrier(0);
        }
        if (j + 1 < nstages) WGB_WRITE(buf ^ 1);
        __syncthreads();
    }
#undef WGB_LOAD
#undef WGB_WRITE
}
__device__ __forceinline__ void rope_frag_pair(bf16x8& a, bf16x8& b, const float* cs, const float* sn) {
    const v4u ua = __builtin_bit_cast(v4u, a), ub = __builtin_bit_cast(v4u, b);
    const f32x4 c0 = *(const f32x4*)cs, c1 = *(const f32x4*)(cs + 4), s0 = *(const f32x4*)sn, s1 = *(const f32x4*)(sn + 4);
    const float x1[8] = {bflo(ua.x), bfhi(ua.x), bflo(ua.y), bfhi(ua.y), bflo(ua.z), bfhi(ua.z), bflo(ua.w), bfhi(ua.w)};
    const float x2[8] = {bflo(ub.x), bfhi(ub.x), bflo(ub.y), bfhi(ub.y), bflo(ub.z), bfhi(ub.z), bflo(ub.w), bfhi(ub.w)};
    const float c[8] = {c0.x, c0.y, c0.z, c0.w, c1.x, c1.y, c1.z, c1.w}, s[8] = {s0.x, s0.y, s0.z, s0.w, s1.x, s1.y, s1.z, s1.w};
    float y1[8], y2[8];
#pragma unroll
    for (int e = 0; e < 8; ++e) { y1[e] = x1[e] * c[e] - x2[e] * s[e]; y2[e] = x2[e] * c[e] + x1[e] * s[e]; }
    v4u oa, ob;
    oa.x = cvtpk(y1[0], y1[1]); oa.y = cvtpk(y1[2], y1[3]); oa.z = cvtpk(y1[4], y1[5]); oa.w = cvtpk(y1[6], y1[7]);
    ob.x = cvtpk(y2[0], y2[1]); ob.y = cvtpk(y2[2], y2[3]); ob.z = cvtpk(y2[4], y2[5]); ob.w = cvtpk(y2[6], y2[7]);
    a = __builtin_bit_cast(bf16x8, oa); b = __builtin_bit_cast(bf16x8, ob);
}
template <int NC>
__device__ __forceinline__ void load_qf(bf16x8 (&qf)[NC], const bf16* qrow, int hi) {
#pragma unroll
    for (int c = 0; c < NC; ++c) qf[c] = *(const bf16x8*)(qrow + 16 * c + 8 * hi);
}
__device__ __forceinline__ void zero_state(f32x16 (&o)[4], float& m, float& l) {
#pragma unroll
    for (int db = 0; db < 4; ++db)
#pragma unroll
        for (int i = 0; i < 16; ++i) o[db][i] = 0.f;
    m = -INFINITY; l = 0.f;
}
__device__ __forceinline__ void store_o(const f32x16 (&o)[4], float l, bf16* orow  , int hi) {
    const float inv = 1.0f / half_sum(l);
#pragma unroll
    for (int db = 0; db < 4; ++db)
#pragma unroll
        for (int ig = 0; ig < 4; ++ig) { v2u w; w.x = cvtpk(o[db][4 * ig] * inv, o[db][4 * ig + 1] * inv); w.y = cvtpk(o[db][4 * ig + 2] * inv, o[db][4 * ig + 3] * inv);
            *(v2u*)(orow + db * 32 + ig * 8 + 4 * hi) = w; }
}
__device__ __forceinline__ void stash_o(const f32x16 (&o)[4], float inv, float* srow, int hi) {
#pragma unroll
    for (int db = 0; db < 4; ++db)
#pragma unroll
        for (int ig = 0; ig < 4; ++ig) *(f32x4*)(srow + db * 32 + ig * 8 + 4 * hi) = (f32x4){o[db][4 * ig] * inv, o[db][4 * ig + 1] * inv, o[db][4 * ig + 2] * inv, o[db][4 * ig + 3] * inv};
}
__device__ __forceinline__ void wg_unit_map(int u, int& bh, int& qb) { const int k = u >> 8, w = u & 255; bh = w >> 3; const int s = w & 7; qb = k ? 15 - s : s; }

#ifndef PROBE_REP_A
#define PROBE_REP_A 1
#endif
#ifndef PROBE_REP_B
#define PROBE_REP_B 1
#endif
#ifndef PROBE_REP_C
#define PROBE_REP_C 1
#endif
#ifndef PROBE_REP_D
#define PROBE_REP_D 1
#endif
struct Args { const float* in[20]; float* out; unsigned char* ws; };

__global__ void __launch_bounds__(NWAVES * 64, 2) mega_fwd(Args args) {
    extern __shared__ __attribute__((aligned(16))) unsigned char lds_raw[];
    cg::grid_group grid = cg::this_grid();
    LAS unsigned char* lds = (LAS unsigned char*)lds_raw;
    typedef const Args __attribute__((address_space(4))) CArgs;
    CArgs* kp = (CArgs*)__builtin_amdgcn_kernarg_segment_ptr();
#define X    (ap->out)
#define H    ((bf16*)(ap->ws + (layer ? WS_HB : WS_H)))
#define HOTHER ((bf16*)(ap->ws + (layer ? WS_H : WS_HB)))
#define ACT  ((bf16*)(ap->ws + WS_ACT))
#define Z    ((bf16*)(ap->ws + WS_Z))
#define O    ((bf16*)(ap->ws + WS_O))
#define T    ((bf16*)(ap->ws + WS_T))
#define QC   ((bf16*)(ap->ws + WS_QC))
#define KV   ((bf16*)(ap->ws + WS_KV))
#define CQN  ((bf16*)(ap->ws + WS_CQN))
#define CKVN ((bf16*)(ap->ws + WS_CKVN))
#define PB   ((bf16*)(ap->ws + WS_PB))
#define cos64  ((float*)(ap->ws + WS_ROPE))
#define sin64  (cos64 + SEQ * 32)
#define cos128 (sin64 + SEQ * 32)
#define sin128 (cos128 + SEQ * 64)
#define KMEAN ((float*)(ap->ws + WS_KMEAN))
#define wl ((LAS float*)(lds + wave * 16384))
    volatile LAS unsigned* bst = (volatile LAS unsigned*)(lds + LDS_BYTES - 64);
    if (threadIdx.x == 0) { bst[0] = 0u; bst[1] = 0u; *(volatile LAS int*)(lds + LDS_BYTES - 4096 + 1024) = -1; }
    if (blockIdx.x == 0) { unsigned* bw = (unsigned*)args.ws; for (int i = threadIdx.x; i < XCD_BAR_WORDS; i += NWAVES * 64) bw[i] = 0u; }
    __syncthreads();
    int wavev = __builtin_amdgcn_readfirstlane(threadIdx.x >> 6), Gv = gridDim.x, bxv = blockIdx.x;
    constexpr int NSTEPS = 20;
    int rep_ = 0;
#pragma unroll 1
    for (int step = 0; step <= NSTEPS - 1; ) {
        unsigned ones_ = ~0u; asm volatile("" : "+s"(kp), "+s"(wavev), "+s"(Gv), "+s"(bxv), "+s"(ones_)); CArgs* ap = kp;
        const int lane = (int)__builtin_amdgcn_mbcnt_hi(ones_, __builtin_amdgcn_mbcnt_lo(ones_, 0u)), wave = wavev, tid = wave * 64 + lane;
        const int G = Gv, bx = bxv;
        const int gw = bx * NWAVES + wave, ngw = G * NWAVES;
        const int vcu = (G % 8 == 0) ? (bx % 8) * (G / 8) + bx / 8 : bx;
        const int layer = (step >= 9) ? 1 : 0;
        const int ls = (step == 0) ? -1 : (layer ? step - 9 : step - 1);
        int code;
        int sub = 0;
        if (step == 0) code = 0;
        else if (layer == 0) {
            switch (ls) { case 0: code = 1; sub = 0; break; case 1: code = 2; sub = 0; break; case 2: code = 4; break; case 3: code = 6; break;
                case 4: code = 7; break; case 5: code = 1; sub = 1; break; case 6: code = 2; sub = 1; break; default: code = 9; break; }
        } else {
            switch (ls) { case 0: code = 1; sub = 0; break; case 1: code = 2; sub = 0; break; case 2: code = 10; break; case 3: code = 11; break; case 4: code = 12; break;
                case 5: code = 14; break; case 6: code = 7; break; case 7: code = 1; sub = 1; break; case 8: code = 2; sub = 1; break; case 9: code = 9; break; default: code = 15; break; }
        }
        code = __builtin_amdgcn_readfirstlane(code); sub = __builtin_amdgcn_readfirstlane(sub);
        float* SS = (float*)(ap->ws + WS_SS);

        if (code == 0) {
            LAS float* scr = wl;
            for (int i = 0; i < 2; ++i) for (int j = 0; j < 2; ++j) {
                conv_matrix(ap->in[3] + (size_t)(i * 2 + j) * D * 2 * DFF, D, 2 * DFF, (bf16*)(ap->ws + WS_WGU + (size_t)(i * 2 + j) * WGU_SZ), 1, scr, lane, gw, ngw, ap->in[2] + (size_t)(i * 2 + j) * D);
                conv_matrix(ap->in[4] + (size_t)(i * 2 + j) * DFF * D, DFF, D, (bf16*)(ap->ws + WS_WDN + (size_t)(i * 2 + j) * WDN_SZ), 0, scr, lane, gw, ngw);
            }
            conv_matrix(ap->in[6], D, AB_IN, (bf16*)(ap->ws + WS_WABIN), 3, scr, lane, gw, ngw, ap->in[5]);
            conv_matrix(ap->in[9], AB_OUT, D, (bf16*)(ap->ws + WS_WABOUT), 0, scr, lane, gw, ngw);
            conv_matrix(ap->in[10], D, CD_IN, (bf16*)(ap->ws + WS_WCDIN), 0, scr, lane, gw, ngw, ap->in[5] + D);
            conv_matrix(ap->in[12], 512, 1536, (bf16*)(ap->ws + WS_WUQ), 0, scr, lane, gw, ngw);
            conv_matrix(ap->in[14], 256, 2048, (bf16*)(ap->ws + WS_WUKV), 2, scr, lane, gw, ngw);
            conv_matrix(ap->in[15], CD_OUT, D, (bf16*)(ap->ws + WS_WCDOUT), 0, scr, lane, gw, ngw);
            for (int i = 0; i < 2; ++i) {
                conv_matrix(ap->in[17] + (size_t)i * D * D, D, D, (bf16*)(ap->ws + WS_WGATE + (size_t)i * WGATE_SZ), 0, scr, lane, gw, ngw, ap->in[16] + (size_t)i * D);
                conv_matrix(ap->in[18] + (size_t)i * PLE * D, PLE, D, (bf16*)(ap->ws + WS_WPROJ + (size_t)i * WPROJ_SZ), 0, scr, lane, gw, ngw);
            }
            {
                const f32x4* ps = (const f32x4*)ap->in[1]; v2u* pd = (v2u*)PB; const int n4 = 2 * M * PLE / 4;
                for (int i = gw * 64 + lane; i < n4; i += ngw * 64) { const f32x4 v = ps[i]; v2u w; w.x = pk2(v.x, v.y); w.y = pk2(v.z, v.w); pd[i] = w; }
            }
            {
                for (int i = gw * 64 + lane; i < SEQ * 96; i += ngw * 64) {
                    int pos, k, dim; float *cd, *sd;
                    if (i < SEQ * 32) { pos = i >> 5; k = i & 31; dim = 64; cd = cos64 + i; sd = sin64 + i; }
                    else { const int i2 = i - SEQ * 32; pos = i2 >> 6; k = i2 & 63; dim = 128; cd = cos128 + i2; sd = sin128 + i2; }
                    const float inv = exp2f(-(float)(2 * k) / (float)dim * 13.287712379549449f);
                    const float ang = (float)pos * inv;
                    double rev = (double)ang * 0.15915494309189535; rev -= floor(rev);
                    const float rf = (float)rev;
                    *cd = __builtin_amdgcn_cosf(rf); *sd = __builtin_amdgcn_sinf(rf);
                }
            }
            for (int m = gw; m < M; m += ngw) first_row(ap->in[0] + (size_t)m * D, (bf16*)(ap->ws + WS_H) + (size_t)m * D, SS + (size_t)m * 32, lane);
        } else if (code == 1) {
            pg8::Gemm g{H, (const bf16*)(ap->ws + WS_WGU + (size_t)(layer * 2 + sub) * WGU_SZ), M, 2 * DFF, D}; pg8::StaticOrder S; S.init(M, 2 * DFF, G, bx);
            pg8::EpiSwiGLU E{ACT, DFF, SS + (size_t)(4 * layer + 2 * sub) * SS_SITE};
            pg8::gemm_phase<pg8::EpiSwiGLU, pg8::StaticOrder, true, true>(lds, g, S, E, wave);
        } else if (code == 2 || code == 7) {
            const bf16* A; const bf16* Bt; int K; float alpha; int sidx;
            if (code == 2) { A = ACT; Bt = (const bf16*)(ap->ws + WS_WDN + (size_t)(layer * 2 + sub) * WDN_SZ); K = DFF; alpha = 0.5f; sidx = 4 * layer + (sub ? 3 : 1); }
            else if (layer == 0) { A = O; Bt = (const bf16*)(ap->ws + WS_WABOUT); K = AB_OUT; alpha = 1.0f; sidx = 2; }
            else { A = O; Bt = (const bf16*)(ap->ws + WS_WCDOUT); K = CD_OUT; alpha = 1.0f; sidx = 6; }
            pg8::Gemm g{A, Bt, M, D, K}; pg8::StaticOrder S; S.init(M, D, G, bx);
            pg8::EpiResidual E{H, SS + (size_t)sidx * SS_SITE, D, alpha};
            pg8::gemm_phase<pg8::EpiResidual, pg8::StaticOrder, true, true>(lds, g, S, E, wave);
        } else if (code == 4 || code == 10 || code == 12) {
            __syncthreads();
            if (code == 4) {
                { pg8::Gemm g{H, (const bf16*)(ap->ws + WS_WABIN), M, 2048, D}; pg8::StaticOrder S; S.init(M, 2048, G, bx); pg8::EpiRope E{Z, AB_IN, SS + (size_t)1 * SS_SITE, cos64, sin64, 32};
                  pg8::gemm_phase<pg8::EpiRope, pg8::StaticOrder, true, true>(lds, g, S, E, wave); }
                __syncthreads();
                { pg8::Gemm g{H, (const bf16*)(ap->ws + WS_WABIN) + (size_t)3072 * D, M, 3072, D}; pg8::StaticOrder S; S.init(M, 3072, G, bx); pg8::EpiRope E{Z + 3072, AB_IN, SS + (size_t)1 * SS_SITE, cos128, sin128, 64};
                  pg8::gemm_phase<pg8::EpiRope, pg8::StaticOrder, true, true>(lds, g, S, E, wave); }
                __syncthreads();
                { pg8::Gemm g2{(const bf16*)(ap->ws + WS_WABIN) + (size_t)2048 * D, H, 1024, M, D}; pg8::StaticOrder S2; S2.init(1024, M, G, bx); pg8::EpiStore E2{(bf16*)(ap->ws + WS_VTA), VTP, nullptr, SS + (size_t)1 * SS_SITE};
                  pg8::gemm_phase<pg8::EpiStore, pg8::StaticOrder, true, true>(lds, g2, S2, E2, wave); }
                __syncthreads();
                { pg8::Gemm g2{(const bf16*)(ap->ws + WS_WABIN) + (size_t)6144 * D, H, 1536, M, D}; pg8::StaticOrder S2; S2.init(1536, M, G, bx); pg8::EpiStore E2{(bf16*)(ap->ws + WS_VTB), VTP, nullptr, SS + (size_t)1 * SS_SITE};
                  pg8::gemm_phase<pg8::EpiStore, pg8::StaticOrder, true, true>(lds, g2, S2, E2, wave); } }
            else if (code == 10) { pg8::Gemm g{H, (const bf16*)(ap->ws + WS_WCDIN), M, 3072, D}; pg8::StaticOrder S; S.init(M, 3072, G, bx); pg8::EpiStore E{Z, CD_INP, SS + (size_t)5 * SS_SITE, nullptr};
                pg8::gemm_phase<pg8::EpiStore, pg8::StaticOrder, true, true>(lds, g, S, E, wave);
                __syncthreads();
                { pg8::Gemm g2{(const bf16*)(ap->ws + WS_WCDIN) + (size_t)2880 * D, H, 1024, M, D}; pg8::StaticOrder S2; S2.init(1024, M, G, bx); pg8::EpiStore E2{(bf16*)(ap->ws + WS_VTD), VTP, nullptr, SS + (size_t)5 * SS_SITE};
                  pg8::gemm_phase<pg8::EpiStore, pg8::StaticOrder, true, true>(lds, g2, S2, E2, wave); } }
            else {
                for (int j = gw; j < NB * 8 * 16; j += ngw) {
                const int blk = j & 15, h = (j >> 4) & 7, b = j >> 7;
                const bf16* kp = Z + (size_t)(b * SEQ + blk * 256) * CD_INP + 1856 + h * 128 + 2 * lane; float s0 = 0.f, s1 = 0.f;
#pragma unroll 16
                for (int t = 0; t < 256; ++t) { const unsigned w = *(const unsigned*)(kp + (size_t)t * CD_INP); s0 += bflo(w); s1 += bfhi(w); }
                KMEAN[(size_t)j * 128 + 2 * lane] = s0 * (1.f / 256.f); KMEAN[(size_t)j * 128 + 2 * lane + 1] = s1 * (1.f / 256.f);
            }
                __syncthreads();
                { pg8::Gemm g{CQN, (const bf16*)(ap->ws + WS_WUQ), M, 1536, 512}; pg8::StaticOrder S; S.init(M, 1536, G, bx); pg8::EpiStore E{QC, 1536, nullptr, nullptr};
                  pg8::gemm_phase<pg8::EpiStore, pg8::StaticOrder, true, true>(lds, g, S, E, wave); }
                __syncthreads();
                { pg8::Gemm g{CKVN, (const bf16*)(ap->ws + WS_WUKV), M, 1024, 256}; pg8::StaticOrder S; S.init(M, 1024, G, bx); pg8::EpiStore E{KV, KV_LD, nullptr, nullptr};
                  pg8::gemm_phase<pg8::EpiStore, pg8::StaticOrder, true, true>(lds, g, S, E, wave); }
                __syncthreads();
                { pg8::Gemm g2{(const bf16*)(ap->ws + WS_WUKV) + (size_t)1024 * 256, CKVN, 1024, M, 256}; pg8::StaticOrder S2; S2.init(1024, M, G, bx); pg8::EpiStore E2{(bf16*)(ap->ws + WS_VTC), VTP, nullptr, nullptr};
                  pg8::gemm_phase<pg8::EpiStore, pg8::StaticOrder, true, true>(lds, g2, S2, E2, wave); }
            }
        } else if (code == 9) {
            { pg8::Gemm g{PB + (size_t)layer * M * PLE, (const bf16*)(ap->ws + WS_WPROJ + (size_t)layer * WPROJ_SZ), M, D, PLE}; pg8::StaticOrder S; S.init(M, D, G, bx); pg8::EpiStore E{T, D, nullptr, nullptr};
              pg8::gemm_phase<pg8::EpiStore, pg8::StaticOrder, true, true>(lds, g, S, E, wave); }
            __syncthreads();
            { pg8::Gemm g{H, (const bf16*)(ap->ws + WS_WGATE + (size_t)layer * WGATE_SZ), M, D, D}; pg8::StaticOrder S; S.init(M, D, G, bx); pg8::EpiGate E{H, T, HOTHER, SS + (size_t)(4 * layer + 4) * SS_SITE, SS + (size_t)(4 * layer + 3) * SS_SITE, D};
              pg8::gemm_phase<pg8::EpiGate, pg8::StaticOrder, true, true>(lds, g, S, E, wave); }
        } else if (code == 5) {
            for (int m = gw; m < M; m += ngw) {
                const int pos = m & (SEQ - 1); bf16* zr = Z + (size_t)m * AB_IN;
#pragma unroll
                for (int ch = lane; ch < 128; ch += 64) { const int grp = ch >> 2, c8 = (ch & 3) * 8; rope8(zr + grp * 64 + c8, 32, cos64 + pos * 32 + c8, sin64 + pos * 32 + c8); }
#pragma unroll
                for (int ch = lane; ch < 192; ch += 64) { const int hd = ch >> 3, c8 = (ch & 7) * 8; rope8(zr + 3072 + hd * 128 + c8, 64, cos128 + pos * 64 + c8, sin128 + pos * 64 + c8); }
            }
        } else if (code == 11) {
            for (int m = gw; m < M; m += ngw) {
                const int pos = m & (SEQ - 1); bf16* zr = Z + (size_t)m * CD_INP;
                small_norm(zr, 512, ap->in[11], CQN + (size_t)m * 512, lane);
                small_norm(zr + 512, 256, ap->in[13], CKVN + (size_t)m * 256, lane);
                if (lane < 4) { const int c8 = lane * 8; rope8(zr + 768 + c8, 32, cos64 + pos * 32 + c8, sin64 + pos * 32 + c8); }
#pragma unroll
                for (int ch = lane; ch < 128; ch += 64) { const int hd = ch >> 3, c8 = (ch & 7) * 8; rope8(zr + 832 + hd * 128 + c8, 64, cos128 + pos * 64 + c8, sin128 + pos * 64 + c8); }
            }
        } else if (code == 6) {
            const float lamA = wave_sum(ap->in[7][lane] * ap->in[7][64 + lane], lane), lamB = wave_sum(ap->in[7][128 + lane] * ap->in[7][192 + lane], lane);
            const float lam = __expf(lamA) - __expf(lamB) + 0.2f;
            const int r32 = lane & 31, hi = lane >> 5;
            float* STASH = (float*)(ap->ws + WS_T);
#pragma unroll 1
            for (int u_ = vcu; u_ < 512 * PROBE_REP_A; u_ += G) { const int u = u_ & 511;
                int bh, qb; wg_unit_map(u, bh, qb);
                const int b = bh >> 3, h = bh & 7, tokb = b * SEQ, q0 = qb * 256, qw = q0 + 32 * wave;
                const bf16* vt = (const bf16*)(ap->ws + WS_VTA) + (size_t)(h * 128) * VTP;
                f32x16 o[4]; float m_, l_;
#pragma unroll 1
                for (int mp = 0; mp < 2; ++mp) {
                    bf16x8 qf[4]; load_qf<4>(qf, Z + (size_t)(tokb + qw + r32) * AB_IN + h * 128 + mp * 64, hi);
                    zero_state(o, m_, l_);
                    CtlCausal ctl{qw, r32, hi, false, 0, 0u};
                    wg_attention128<4, CtlCausal>(lds, Z + 1024 + h * 128 + mp * 64, AB_IN, vt, tokb, 0, (q0 + 256) >> 7, qf, 0.125f * 1.4426950408889634f, ctl, o, m_, l_, tid, r32, hi);
                    const float inv = 1.0f / half_sum(l_);
                    float* srow = STASH + (size_t)(tokb + qw + r32) * 1024 + h * 128;
                    if (mp == 0) stash_o(o, inv, srow, hi);
                    else {
                        float ss = 0.f;
#pragma unroll
                        for (int db = 0; db < 4; ++db)
#pragma unroll
                            for (int ig = 0; ig < 4; ++ig) { const f32x4 o1 = *(const f32x4*)(srow + db * 32 + ig * 8 + 4 * hi);
#pragma unroll
                                for (int e = 0; e < 4; ++e) { const float a = o1[e] - lam * (o[db][4 * ig + e] * inv); o[db][4 * ig + e] = a; ss += a * a; } }
                        ss = half_sum(ss);
                        const float rstd = rsqrtf(ss * (1.f / 128.f) + EPS) * 0.8f;
                        bf16* orow = O + (size_t)(tokb + qw + r32) * AB_OUT + h * 128;
#pragma unroll
                        for (int db = 0; db < 4; ++db)
#pragma unroll
                            for (int ig = 0; ig < 4; ++ig) { const f32x4 gn = *(const f32x4*)(ap->in[8] + db * 32 + ig * 8 + 4 * hi); v2u w;
                                w.x = cvtpk(o[db][4 * ig] * rstd * gn.x, o[db][4 * ig + 1] * rstd * gn.y); w.y = cvtpk(o[db][4 * ig + 2] * rstd * gn.z, o[db][4 * ig + 3] * rstd * gn.w);
                                *(v2u*)(orow + db * 32 + ig * 8 + 4 * hi) = w; }
                    }
                }
            }
#pragma unroll 1
            for (int u_ = vcu; u_ < 256 * PROBE_REP_B; u_ += G) { const int u = u_ & 255;
                const int b = u >> 6, hh = (u >> 4) & 3, qb = u & 15, tokb = b * SEQ, q0 = qb * 256, qw = q0 + 32 * wave;
                f32x16 o[4]; float m_, l_; zero_state(o, m_, l_);
#pragma unroll 1
                for (int g = 0; g < 3; ++g) {
                    const int hd = g * 4 + hh, dil = 1 << (2 * g), window = 128 << (2 * g);
                    const int kvs = (q0 > window) ? q0 - window : 0, nst = (q0 + 256 - kvs) >> 6;
                    bf16x8 qf[8]; load_qf<8>(qf, Z + (size_t)(tokb + qw + r32) * AB_IN + 3072 + hd * 128, hi);
                    CtlDil ctl{qw, r32, hi, window, dil - 1};
                    wg_attention128<8, CtlDil>(lds, Z + 4608 + hd * 128, AB_IN, (const bf16*)(ap->ws + WS_VTB) + (size_t)(hd * 128) * VTP, tokb + kvs, kvs, (q0 + 256 - kvs) >> 7, qf, 0.08838834764831845f * 1.4426950408889634f, ctl, o, m_, l_, tid, r32, hi);
                }
                store_o(o, l_, O + (size_t)(tokb + qw + r32) * AB_OUT + 1024 + hh * 128, hi);
            }
        } else if (code == 14) {
#pragma unroll 1
            for (int u_ = vcu; u_ < 512 * PROBE_REP_C; u_ += G) { const int u = u_ & 511;
                int bh, qb; wg_unit_map(u, bh, qb);
                const int ln_ = pg8::fresh_lane(), r32 = ln_ & 31, hi = ln_ >> 5, tid = wave * 64 + ln_;
                const int b = bh >> 3, h = bh & 7, tokb = b * SEQ, q0 = qb * 256, qw = q0 + 32 * wave;
                bf16x8 qf[12]; load_qf<12>(qf, QC + (size_t)(tokb + qw + r32) * 1536 + h * 192, hi);
                { const int pos = qw + r32;
                  rope_frag_pair(qf[8], qf[10], cos64 + pos * 32 + 8 * hi, sin64 + pos * 32 + 8 * hi); rope_frag_pair(qf[9], qf[11], cos64 + pos * 32 + 16 + 8 * hi, sin64 + pos * 32 + 16 + 8 * hi); }
                f32x16 o[4]; float m_, l_; zero_state(o, m_, l_);
                CtlCausal ctl{qw, r32, hi, false, 0, 0u};
                wg_attention<8, 4, CtlCausal>(lds, KV + h * 128, KV_LD, Z + 768, CD_INP, (const bf16*)(ap->ws + WS_VTC) + (size_t)(h * 128) * VTP, tokb, 0, (q0 + 256) >> 6, qf, 0.07216878364870322f * 1.4426950408889634f, ctl, o, m_, l_, tid, r32, hi);
                store_o(o, l_, O + (size_t)(tokb + qw + r32) * CD_OUT + h * 128, hi);
            }
#pragma unroll 1
            for (int u_ = vcu; u_ < 512 * PROBE_REP_D; u_ += G) { const int u = u_ & 511;
                int bh, qb; wg_unit_map(u, bh, qb);
                const int ln_ = pg8::fresh_lane(), r32 = ln_ & 31, hi = ln_ >> 5, tid = wave * 64 + ln_;
                const int b = bh >> 3, h = bh & 7, tokb = b * SEQ, q0 = qb * 256, qw = q0 + 32 * wave, own = qb;
                const bf16* qrow = Z + (size_t)(tokb + qw + r32) * CD_INP + 832 + h * 128;
                float g8[8];
#pragma unroll
                for (int j = 0; j < 8; ++j) g8[j] = 0.f;
                const float* km = KMEAN + (size_t)((b * 8 + h) * 16 + 8 * hi) * 128;
#pragma unroll 2
                for (int d0 = 0; d0 < 128; d0 += 8) {
                    const v4u qw4 = *(const v4u*)(qrow + d0);
                    const float q8[8] = {bflo(qw4.x), bfhi(qw4.x), bflo(qw4.y), bfhi(qw4.y), bflo(qw4.z), bfhi(qw4.z), bflo(qw4.w), bfhi(qw4.w)};
#pragma unroll
                    for (int j = 0; j < 8; ++j) { const f32x4 k0 = *(const f32x4*)(km + j * 128 + d0), k1 = *(const f32x4*)(km + j * 128 + d0 + 4);
                        g8[j] += q8[0] * k0.x + q8[1] * k0.y + q8[2] * k0.z + q8[3] * k0.w + q8[4] * k1.x + q8[5] * k1.y + q8[6] * k1.z + q8[7] * k1.w; }
                }
                float G16[16];
#pragma unroll
                for (int j = 0; j < 8; ++j) { float glo, ghi; half_pair(g8[j], glo, ghi); G16[j] = glo; G16[8 + j] = ghi; }
#pragma unroll
                for (int n = 0; n < 16; ++n) G16[n] = (n < own) ? G16[n] : -INFINITY;
                unsigned selmask = 0u;
#pragma unroll
                for (int k = 0; k < 3; ++k) { float best = -INFINITY; int bi = -1;
#pragma unroll
                    for (int n = 0; n < 16; ++n) if (G16[n] > best) { best = G16[n]; bi = n; }
                    if (bi >= 0) selmask |= 1u << bi;
#pragma unroll
                    for (int n = 0; n < 16; ++n) G16[n] = (n == bi) ? -INFINITY : G16[n]; }
                bf16x8 qf[8]; load_qf<8>(qf, qrow, hi);
                f32x16 o[4]; float m_, l_; zero_state(o, m_, l_);
                CtlCausal ctl{qw, r32, hi, true, own, selmask};
                wg_attention128<8, CtlCausal>(lds, Z + 1856 + h * 128, CD_INP, (const bf16*)(ap->ws + WS_VTD) + (size_t)(h * 128) * VTP, tokb, 0, (q0 + 256) >> 7, qf, 0.08838834764831845f * 1.4426950408889634f, ctl, o, m_, l_, tid, r32, hi);
                store_o(o, l_, O + (size_t)(tokb + qw + r32) * CD_OUT + 1024 + h * 128, hi);
            }
        } else {
            for (int m = gw; m < M; m += ngw) { const float sv = (lane < 32) ? SS[(size_t)8 * SS_SITE + (size_t)m * 32 + lane] : 0.f; final_norm_row((const bf16*)(ap->ws + WS_H) + (size_t)m * D, X + (size_t)m * D, ap->in[19], wave_sum(sv, lane), lane); }
        }
#ifdef PROBE_DUP_MASK
        if (((PROBE_DUP_MASK >> code) & 1u) && rep_ == 0) { rep_ = 1; __syncthreads(); continue; }
        rep_ = 0;
#endif
        if (step == 0) { grid.sync(); (void)xcd_barrier_post((unsigned*)ap->ws, bst); }
        else if (step != NSTEPS - 1) { XcdBarrier xb; xb.bar = (unsigned*)ap->ws; xb.x = xb_xcc_id(); xb.st = bst; xcd_barrier(xb); }

        ++step;
    }
}

#undef X
#undef H
#undef HOTHER
#undef ACT
#undef Z
#undef O
#undef T
#undef QC
#undef KV
#undef CQN
#undef CKVN
#undef PB
#undef cos64
#undef sin64
#undef cos128
#undef sin128
#undef KMEAN
#undef wl
extern "C" void kernel_launch(void* const* d_in, const int* in_sizes, int n_in, void* d_out, int out_size, void* d_ws, size_t ws_size, hipStream_t stream) {
    static int grid = 0;
    if (grid == 0) {
        if (n_in != 20 || out_size != M * D || ws_size < WS_END) { fprintf(stderr, "kernel_launch: unexpected problem (n_in %d, out %d, ws %zu)\n", n_in, out_size, ws_size); grid = -1; return; }
        int dev = 0, cus = 0, per_cu = 0;
        hipGetDevice(&dev); hipDeviceGetAttribute(&cus, hipDeviceAttributeMultiprocessorCount, dev);
        if (hipFuncSetAttribute((const void*)mega_fwd, hipFuncAttributeMaxDynamicSharedMemorySize, LDS_BYTES) != hipSuccess) { fprintf(stderr, "kernel_launch: hipFuncSetAttribute failed\n"); grid = -1; return; }
        if (hipOccupancyMaxActiveBlocksPerMultiprocessor(&per_cu, (const void*)mega_fwd, NWAVES * 64, LDS_BYTES) != hipSuccess || per_cu < 1) { fprintf(stderr, "kernel_launch: occupancy query says %d\n", per_cu); per_cu = 1; }
        (void)hipGetLastError();
        grid = cus * 1;
    }
    if (grid < 0) return;
    Args a{};
    for (int i = 0; i < 20; ++i) a.in[i] = (const float*)d_in[i];
    a.out = (float*)d_out; a.ws = (unsigned char*)d_ws;
    void* kargs[] = {&a};
    hipError_t e = hipLaunchCooperativeKernel((const void*)mega_fwd, dim3(grid), dim3(NWAVES * 64), kargs, LDS_BYTES, stream);
    if (e != hipSuccess) fprintf(stderr, "cooperative launch failed: %s (grid %d)\n", hipGetErrorString(e), grid);
}
```

```cpp
#include <hip/hip_runtime.h>
#include <hip/hip_cooperative_groups.h>
#include <cstdio>
#include <cstdint>
#include <cmath>
namespace cg = cooperative_groups;
namespace pg8 {
#define PG8_LAS __attribute__((address_space(3)))
typedef unsigned short bf16_t;
typedef short bf16x8 __attribute__((ext_vector_type(8)));
typedef float f32x4 __attribute__((ext_vector_type(4)));
typedef unsigned u32x4 __attribute__((ext_vector_type(4)));
constexpr int BM = 256, BK = 64, HALF = 128, HTB = HALF * BK * 2  , STAGE_BYTES = 8 * HTB, NXCD = 8, WGM = 8;

__host__ __device__ __forceinline__ int lds_byte(int r, int c) { const int st = (r >> 4) * 2 + (c >> 5), rr = r & 15, cc = c & 31, ob = rr * 64 + cc * 2; return st * 1024 + (ob ^ (((ob >> 9) & 1) << 5)); }
__host__ __device__ __forceinline__ void stage_rc(int b, int& R, int& C) { const int st = b / 1024, sb = b % 1024, swz = sb ^ (((sb >> 9) & 1) << 5); R = (st >> 1) * 16 + swz / 64; C = (st & 1) * 32 + (swz % 64) / 2; }
__host__ __device__ __forceinline__ int perm32(int rho) { const int n = rho >> 4, i = rho & 15; return 8 * (i >> 2) + 4 * n + (i & 3); }

struct Unit { int pm, pn; };
struct Gemm { const bf16_t* A; const bf16_t* Bt; int M, N, K; };

struct StaticOrder {
    int nM, nN, nwg, G, c;
    __host__ __device__ void init(int M, int N, int G_, int c_) { nM = M / BM; nN = N / BM; nwg = nM * nN; G = G_; c = c_; }
    __host__ __device__ bool next(int i, Unit& u) const {
        const long L = (long)i * G + c; if (L >= nwg) return false;
        int wgid = (int)L; { const int q = nwg / NXCD, r = nwg % NXCD, xcd = wgid % NXCD, off = wgid / NXCD; wgid = (xcd < r ? xcd * (q + 1) : r * (q + 1) + (xcd - r) * q) + off; }
        const int nig = WGM * nN, gid = wgid / nig, fm = gid * WGM, gsz = (nM - fm) < WGM ? (nM - fm) : WGM;
        u.pm = fm + ((wgid % nig) % gsz); u.pn = (wgid % nig) / gsz; return true;
    }
    __device__ __forceinline__ void a_ready(const Unit&) const {}
    __device__ __forceinline__ void done(const Unit&) const {}
};

__device__ __forceinline__ unsigned cvt_pk_bf16(float lo, float hi) { unsigned r; asm volatile("v_cvt_pk_bf16_f32 %0, %1, %2" : "=v"(r) : "v"(lo), "v"(hi)); return r; }
typedef float f32x2 __attribute__((ext_vector_type(2)));
constexpr float RMS_INV_D = 1.0f / 2048.0f, RMS_EPS = 1e-6f;
typedef __attribute__((address_space(3))) float lds_f32;
__device__ __forceinline__ lds_f32* stats_tab() { return (lds_f32*)(size_t)(147456 - 4096); }
__device__ __forceinline__ void stats_table(const float* ss, int base, int tid) {
    typedef __attribute__((address_space(3))) int lds_i32;
    lds_i32* tag = (lds_i32*)(stats_tab() + 256);
    const int want = (int)((size_t)ss >> 7) + base;
    const int have = __builtin_amdgcn_readfirstlane(*tag);
    if (have == want) return;
    const f32x4* p = (const f32x4*)(ss + (size_t)(base + (tid >> 1)) * 32 + (tid & 1) * 16);
    const f32x4 a = (p[0] + p[1]) + (p[2] + p[3]);
    float s = (a[0] + a[1]) + (a[2] + a[3]);
    s += __int_as_float(__builtin_amdgcn_ds_bpermute(((tid & 63) ^ 1) << 2, __float_as_int(s)));
    if ((tid & 1) == 0) stats_tab()[tid >> 1] = __builtin_amdgcn_rsqf(s * RMS_INV_D + RMS_EPS);
    asm volatile("s_waitcnt lgkmcnt(0)\n\ts_barrier" ::: "memory");
    if (tid == 0) *tag = want;
}
struct EpiStore {
    static constexpr bool PERM = true, AFTER_DRAIN = false;
    bf16_t* O; int ldc; const float* rs; const float* cs;
    __device__ __forceinline__ void operator()(const f32x4 (&acc)[2][2][4][2], const Unit& u, int wr, int wc, int fr, int fq) const {
        const int row0 = u.pm * BM + wr * 64 + fr; const int col0 = u.pn * BM + wc * 32 + 8 * fq;
        const int tid = (wr * 4 + wc) * 64 + fq * 16 + fr;
        if (rs) stats_table(rs, u.pm * BM, tid); else if (cs) stats_table(cs, u.pn * BM, tid);
        const lds_f32* tab = stats_tab();
        float cv[2][8];
#pragma unroll
        for (int bj = 0; bj < 2; ++bj)
#pragma unroll
            for (int e = 0; e < 8; ++e) cv[bj][e] = cs ? tab[wc * 32 + 8 * fq + bj * HALF + e] : 1.0f;
#pragma unroll
        for (int ai = 0; ai < 2; ++ai)
#pragma unroll
            for (int m = 0; m < 4; ++m) { const int rl = wr * 64 + fr + ai * HALF + m * 16; bf16_t* rowp = O + (size_t)(u.pm * BM + rl) * ldc + col0; const float rsc = rs ? tab[rl] : 1.0f;
#pragma unroll
                for (int bj = 0; bj < 2; ++bj) { const f32x4 v0 = acc[ai][bj][m][0] * rsc, v1 = acc[ai][bj][m][1] * rsc;
                    u32x4 w; w.x = cvt_pk_bf16(v0[0] * cv[bj][0], v0[1] * cv[bj][1]); w.y = cvt_pk_bf16(v0[2] * cv[bj][2], v0[3] * cv[bj][3]);
                    w.z = cvt_pk_bf16(v1[0] * cv[bj][4], v1[1] * cv[bj][5]); w.w = cvt_pk_bf16(v1[2] * cv[bj][6], v1[3] * cv[bj][7]);
                    *(u32x4*)(rowp + bj * HALF) = w; } }
    }
};
struct EpiRope {
    static constexpr bool PERM = true, AFTER_DRAIN = false;
    bf16_t* O; int ldc; const float* rs; const float* cs; const float* sn; int half;
    __device__ __forceinline__ void operator()(const f32x4 (&acc)[2][2][4][2], const Unit& u, int wr, int wc, int fr, int fq) const {
        typedef unsigned u32x2 __attribute__((ext_vector_type(2)));
        const int tid = (wr * 4 + wc) * 64 + fq * 16 + fr;
        stats_table(rs, u.pm * BM, tid); const lds_f32* tab = stats_tab();
        const int d0 = (half == 64) ? 16 * wc + 4 * fq : 16 * (wc & 1) + 4 * fq;
        const int gcol = u.pn * BM + ((half == 64) ? 0 : 64 * (wc >> 1)) + d0;
#pragma unroll
        for (int ai = 0; ai < 2; ++ai)
#pragma unroll
            for (int m = 0; m < 4; ++m) { const int rl = wr * 64 + fr + ai * HALF + m * 16, row = u.pm * BM + rl; const float rsc = tab[rl];
                const f32x4 c = *(const f32x4*)(cs + (size_t)(row & 4095) * half + d0), s = *(const f32x4*)(sn + (size_t)(row & 4095) * half + d0);
                bf16_t* rowp = O + (size_t)row * ldc + gcol;
#pragma unroll
                for (int bj = 0; bj < 2; ++bj) { const f32x4 x1 = acc[ai][bj][m][0] * rsc, x2 = acc[ai][bj][m][1] * rsc;
                    const f32x4 y1 = x1 * c - x2 * s, y2 = x2 * c + x1 * s;
                    u32x2 w1, w2; w1.x = cvt_pk_bf16(y1[0], y1[1]); w1.y = cvt_pk_bf16(y1[2], y1[3]); w2.x = cvt_pk_bf16(y2[0], y2[1]); w2.y = cvt_pk_bf16(y2[2], y2[3]);
                    *(u32x2*)(rowp + bj * HALF) = w1; *(u32x2*)(rowp + bj * HALF + half) = w2; } }
    }
};
__device__ __forceinline__ float silu_mul(float g, float u) { return g * __builtin_amdgcn_rcpf(1.0f + __expf(-g)) * u; }
struct EpiSwiGLU {
    static constexpr bool PERM = true, AFTER_DRAIN = false;
    bf16_t* O; int ldc; const float* rs;
    __device__ __forceinline__ void operator()(const f32x4 (&acc)[2][2][4][2], const Unit& u, int wr, int wc, int fr, int fq) const {
        const int row0 = u.pm * BM + wr * 64 + fr; const int col0 = u.pn * HALF + wc * 32 + 8 * fq;
        stats_table(rs, u.pm * BM, (wr * 4 + wc) * 64 + fq * 16 + fr); const lds_f32* tab = stats_tab();
#pragma unroll
        for (int ai = 0; ai < 2; ++ai)
#pragma unroll
            for (int m = 0; m < 4; ++m) { const int row = row0 + ai * HALF + m * 16; bf16_t* rowp = O + (size_t)row * ldc + col0; const float rsc = tab[wr * 64 + fr + ai * HALF + m * 16];
                const f32x4 g0 = acc[ai][0][m][0] * rsc, g1 = acc[ai][0][m][1] * rsc, u0 = acc[ai][1][m][0] * rsc, u1 = acc[ai][1][m][1] * rsc;
                u32x4 w;
                w.x = cvt_pk_bf16(silu_mul(g0[0], u0[0]), silu_mul(g0[1], u0[1])); w.y = cvt_pk_bf16(silu_mul(g0[2], u0[2]), silu_mul(g0[3], u0[3]));
                w.z = cvt_pk_bf16(silu_mul(g1[0], u1[0]), silu_mul(g1[1], u1[1])); w.w = cvt_pk_bf16(silu_mul(g1[2], u1[2]), silu_mul(g1[3], u1[3]));
                *(u32x4*)(rowp) = w; }
    }
};
__device__ __forceinline__ void publish_row(const f32x4 (&xn)[2][2], bf16_t* xbrow, float* ssrow, int fq, int lane) {
    typedef unsigned u32x2 __attribute__((ext_vector_type(2)));
    float q = 0.f;
#pragma unroll
    for (int bj = 0; bj < 2; ++bj)
#pragma unroll
        for (int n = 0; n < 2; ++n) { const f32x4 v = xn[bj][n]; q += (v[0] * v[0] + v[1] * v[1]) + (v[2] * v[2] + v[3] * v[3]);
            u32x2 w; w.x = cvt_pk_bf16(v[0], v[1]); w.y = cvt_pk_bf16(v[2], v[3]); *(u32x2*)(xbrow + bj * HALF + n * 16) = w; }
    q += __int_as_float(__builtin_amdgcn_ds_bpermute((lane ^ 16) << 2, __float_as_int(q)));
    q += __int_as_float(__builtin_amdgcn_ds_bpermute((lane ^ 32) << 2, __float_as_int(q)));
    if (fq == 0) *ssrow = q;
}
constexpr int EPI_DP = 3;
__device__ __forceinline__ void publish_row_p(const f32x4 (&xn)[2][2], bf16_t* xbrow, float* ssrow, int fq, int lane) {
    float q = 0.f;
#pragma unroll
    for (int bj = 0; bj < 2; ++bj) { const f32x4 v0 = xn[bj][0], v1 = xn[bj][1];
        q += ((v0[0] * v0[0] + v0[1] * v0[1]) + (v0[2] * v0[2] + v0[3] * v0[3])) + ((v1[0] * v1[0] + v1[1] * v1[1]) + (v1[2] * v1[2] + v1[3] * v1[3]));
        u32x4 w; w.x = cvt_pk_bf16(v0[0], v0[1]); w.y = cvt_pk_bf16(v0[2], v0[3]); w.z = cvt_pk_bf16(v1[0], v1[1]); w.w = cvt_pk_bf16(v1[2], v1[3]); *(u32x4*)(xbrow + bj * HALF) = w; }
    q += __int_as_float(__builtin_amdgcn_ds_bpermute((lane ^ 16) << 2, __float_as_int(q)));
    q += __int_as_float(__builtin_amdgcn_ds_bpermute((lane ^ 32) << 2, __float_as_int(q)));
    if (fq == 0) *ssrow = q;
}
__device__ __forceinline__ void unpack8(const u32x4 w, f32x4& a, f32x4& b) {
    a[0] = __uint_as_float(w.x << 16); a[1] = __uint_as_float(w.x & 0xffff0000u); a[2] = __uint_as_float(w.y << 16); a[3] = __uint_as_float(w.y & 0xffff0000u);
    b[0] = __uint_as_float(w.z << 16); b[1] = __uint_as_float(w.z & 0xffff0000u); b[2] = __uint_as_float(w.w << 16); b[3] = __uint_as_float(w.w & 0xffff0000u);
}
struct EpiResidual {
    static constexpr bool PERM = true, AFTER_DRAIN = false;
    bf16_t* S; float* ss; int ldc; float alpha;
    __device__ __forceinline__ void operator()(const f32x4 (&acc)[2][2][4][2], const Unit& u, int wr, int wc, int fr, int fq) const {
        const int row0 = u.pm * BM + wr * 64 + fr; const int col0 = u.pn * BM + wc * 32 + 8 * fq; const int lane = fq * 16 + fr;
        u32x4 xv[2], xnext[2];
#pragma unroll
        for (int bj = 0; bj < 2; ++bj) xnext[bj] = *(const u32x4*)(S + (size_t)row0 * ldc + col0 + bj * HALF);
#pragma unroll
        for (int r = 0; r < 8; ++r) { const int ai = r >> 2, m = r & 3; const int row = row0 + ai * HALF + m * 16;
#pragma unroll
            for (int bj = 0; bj < 2; ++bj) xv[bj] = xnext[bj];
            if (r < 7) { const int rown = row0 + ((r + 1) >> 2) * HALF + ((r + 1) & 3) * 16;
#pragma unroll
                for (int bj = 0; bj < 2; ++bj) xnext[bj] = *(const u32x4*)(S + (size_t)rown * ldc + col0 + bj * HALF); }
            f32x4 xn[2][2];
#pragma unroll
            for (int bj = 0; bj < 2; ++bj) { f32x4 a, b; unpack8(xv[bj], a, b); xn[bj][0] = a + acc[ai][bj][m][0] * alpha; xn[bj][1] = b + acc[ai][bj][m][1] * alpha; }
            publish_row_p(xn, S + (size_t)row * ldc + col0, ss + (size_t)row * 32 + u.pn * 4 + wc, fq, lane); }
    }
};
struct EpiGate {
    static constexpr bool PERM = true, AFTER_DRAIN = false;
    const bf16_t* Sin; const bf16_t* T; bf16_t* Sout; float* ss; const float* rs; int ldc;
    __device__ __forceinline__ void operator()(const f32x4 (&acc)[2][2][4][2], const Unit& u, int wr, int wc, int fr, int fq) const {
        const int row0 = u.pm * BM + wr * 64 + fr; const int col0 = u.pn * BM + wc * 32 + 8 * fq; const int lane = fq * 16 + fr;
        stats_table(rs, u.pm * BM, (wr * 4 + wc) * 64 + lane); const lds_f32* tab = stats_tab();
        u32x4 xv[2], xnext[2], tv[2], tnext[2];
#pragma unroll
        for (int bj = 0; bj < 2; ++bj) { const size_t o_ = (size_t)row0 * ldc + col0 + bj * HALF; xnext[bj] = *(const u32x4*)(Sin + o_); tnext[bj] = *(const u32x4*)(T + o_); }
#pragma unroll
        for (int r = 0; r < 8; ++r) { const int ai = r >> 2, m = r & 3; const int row = row0 + ai * HALF + m * 16; const size_t off = (size_t)row * ldc + col0; const float rsc = tab[wr * 64 + fr + ai * HALF + m * 16];
#pragma unroll
            for (int bj = 0; bj < 2; ++bj) { xv[bj] = xnext[bj]; tv[bj] = tnext[bj]; }
            if (r < 7) { const int rown = row0 + ((r + 1) >> 2) * HALF + ((r + 1) & 3) * 16;
#pragma unroll
                for (int bj = 0; bj < 2; ++bj) { const size_t o_ = (size_t)rown * ldc + col0 + bj * HALF; xnext[bj] = *(const u32x4*)(Sin + o_); tnext[bj] = *(const u32x4*)(T + o_); } }
            f32x4 xn[2][2];
#pragma unroll
            for (int bj = 0; bj < 2; ++bj) { f32x4 xa, xb, ta, tb; unpack8(xv[bj], xa, xb); unpack8(tv[bj], ta, tb);
                const f32x4 a0 = acc[ai][bj][m][0] * rsc, a1 = acc[ai][bj][m][1] * rsc;
#pragma unroll
                for (int e_ = 0; e_ < 4; ++e_) { xn[bj][0][e_] = xa[e_] + __builtin_amdgcn_rcpf(1.0f + __expf(-a0[e_])) * ta[e_]; xn[bj][1][e_] = xb[e_] + __builtin_amdgcn_rcpf(1.0f + __expf(-a1[e_])) * tb[e_]; } }
            publish_row_p(xn, Sout + off, ss + (size_t)row * 32 + u.pn * 4 + wc, fq, lane); }
    }
};
__device__ __forceinline__ int fresh_lane() { unsigned o_ = ~0u; asm volatile("" : "+s"(o_)); return (int)__builtin_amdgcn_mbcnt_hi(o_, __builtin_amdgcn_mbcnt_lo(o_, 0u)); }
template <class Epi, class Sched, bool ALIGN_EPI = false, bool SP2 = false>
__device__ __forceinline__ void gemm_phase(PG8_LAS unsigned char* lds, const Gemm g, const Sched& S, const Epi& E, const int wid) {
    const int lane = fresh_lane(), tid = wid * 64 + lane, wr = wid >> 2, wc = wid & 3;
    const int K = g.K, nt = K / BK;
    unsigned voffA[2], voffB[2];
#pragma unroll
    for (int i = 0; i < 2; ++i) { int R, C; stage_rc(tid * 16 + i * 8192, R, C); const int Rb = Epi::PERM ? ((R & ~31) + perm32(R & 31)) : R;
        voffA[i] = (unsigned)(R * K + C) * 2u; voffB[i] = (unsigned)(Rb * K + C) * 2u; }
    const size_t kstep = (size_t)(BK * 2);
    const size_t hstep = (size_t)HALF * K * 2;
    const size_t tstep = 2 * hstep;
    const unsigned ldsw = (unsigned)wid * 1024u;
    const int aoff = lds_byte(wr * 64 + (lane & 15), (lane >> 4) * 8), boff = lds_byte(wc * 32 + (lane & 15), (lane >> 4) * 8);
#define PG8_SA(b, h) (((b) * 2 + (h)) * HTB)
#define PG8_SB(b, h) ((4 + (b) * 2 + (h)) * HTB)
#define PG8_STAGE(bufoff, gbase, voff) do { _Pragma("unroll") for (int _i = 0; _i < 2; ++_i) \
        __builtin_amdgcn_global_load_lds((const unsigned*)((const char*)(gbase) + (voff)[_i]), (PG8_LAS unsigned*)(lds + (bufoff) + ldsw + _i * 8192), 16, 0, 0); } while (0)
#define PG8_LDA(dst, b, h) do { _Pragma("unroll") for (int m = 0; m < 4; ++m) _Pragma("unroll") for (int k = 0; k < 2; ++k) dst[m][k] = *(const PG8_LAS bf16x8*)(lds + PG8_SA(b, h) + aoff + m * 2048 + k * 1024); } while (0)
#define PG8_LDB(dst, b, h) do { _Pragma("unroll") for (int n = 0; n < 2; ++n) _Pragma("unroll") for (int k = 0; k < 2; ++k) dst[n][k] = *(const PG8_LAS bf16x8*)(lds + PG8_SB(b, h) + boff + n * 2048 + k * 1024); } while (0)
#define PG8_MMA(ai, bj, At, Bt) do { __builtin_amdgcn_s_setprio(1); _Pragma("unroll") for (int m = 0; m < 4; ++m) _Pragma("unroll") for (int n = 0; n < 2; ++n) _Pragma("unroll") for (int k = 0; k < 2; ++k) \
        acc[ai][bj][m][n] = __builtin_amdgcn_mfma_f32_16x16x32_bf16(Bt[n][k], At[m][k], acc[ai][bj][m][n], 0, 0, 0); __builtin_amdgcn_s_setprio(0); } while (0)
#define PG8_WAIT_V(n) asm volatile("s_waitcnt vmcnt(" #n ")" ::: "memory")
#define PG8_WAIT_L(n) asm volatile("s_waitcnt lgkmcnt(" #n ")" ::: "memory")
#define PG8_BAR __builtin_amdgcn_s_barrier()
#define PG8_SCHED __builtin_amdgcn_sched_barrier(0)
    Unit cur, nxt; int ui = 0;
    if (!S.next(0, cur)) return;
    f32x4 acc[2][2][4][2];
    float zf_ = 0.f; asm volatile("" : "+v"(zf_));
#pragma unroll
    for (int a = 0; a < 2; ++a)
#pragma unroll
        for (int b = 0; b < 2; ++b)
#pragma unroll
            for (int m = 0; m < 4; ++m)
#pragma unroll
                for (int n = 0; n < 2; ++n) acc[a][b][m][n] = (f32x4){zf_, zf_, zf_, zf_};
    bf16x8 At[4][2], B0[2][2], B1[2][2];
    const char* cA = (const char*)g.A + (size_t)cur.pm * tstep; const char* cB = (const char*)g.Bt + (size_t)cur.pn * tstep;
    S.a_ready(cur);
    if constexpr (SP2) {
        PG8_STAGE(PG8_SB(0, 0), cB, voffB); PG8_STAGE(PG8_SB(0, 1), cB + hstep, voffB); PG8_STAGE(PG8_SA(0, 0), cA, voffA); PG8_STAGE(PG8_SA(0, 1), cA + hstep, voffA);
        if (wr == 1) PG8_BAR;
        PG8_WAIT_V(2); PG8_BAR;
        PG8_STAGE(PG8_SB(1, 0), cB + kstep, voffB); PG8_STAGE(PG8_SA(1, 0), cA + kstep, voffA); PG8_STAGE(PG8_SB(1, 1), cB + hstep + kstep, voffB);
        PG8_WAIT_V(6); PG8_BAR;
    } else {
        PG8_STAGE(PG8_SB(0, 0), cB, voffB); PG8_STAGE(PG8_SA(0, 0), cA, voffA); PG8_STAGE(PG8_SB(0, 1), cB + hstep, voffB); PG8_STAGE(PG8_SA(0, 1), cA + hstep, voffA);
        if (wr == 1) PG8_BAR;
        PG8_WAIT_V(4); PG8_BAR;
        PG8_STAGE(PG8_SB(1, 0), cB + kstep, voffB); PG8_STAGE(PG8_SA(1, 0), cA + kstep, voffA); PG8_STAGE(PG8_SB(1, 1), cB + hstep + kstep, voffB);
        PG8_WAIT_V(6); PG8_BAR;
    }
    for (;;) {
        const bool has_next = S.next(ui + 1, nxt);
        const char* nA = has_next ? (const char*)g.A + (size_t)nxt.pm * tstep : cA; const char* nB = has_next ? (const char*)g.Bt + (size_t)nxt.pn * tstep : cB;
        for (int t = 0; t < nt; t += 2) {
            const bool last = (t == nt - 2);
            const char* a1 = cA + (size_t)(t + 1) * kstep;
            const char* a2 = last ? nA : cA + (size_t)(t + 2) * kstep; const char* b2 = last ? nB : cB + (size_t)(t + 2) * kstep;
            const char* a3 = a2 + kstep; const char* b3 = b2 + kstep;
            if (last && has_next) S.a_ready(nxt);
            if constexpr (SP2) {
            PG8_LDB(B0, 0, 0); PG8_LDB(B1, 0, 1); PG8_SCHED; PG8_LDA(At, 0, 0); PG8_STAGE(PG8_SA(1, 1), a1 + hstep, voffA);
            PG8_WAIT_V(8); PG8_WAIT_L(0); PG8_BAR; PG8_MMA(0, 0, At, B0); PG8_MMA(0, 1, At, B1); PG8_BAR; PG8_SCHED;
            PG8_LDA(At, 0, 1); PG8_STAGE(PG8_SB(0, 0), b2, voffB); PG8_STAGE(PG8_SB(0, 1), b2 + hstep, voffB); PG8_STAGE(PG8_SA(0, 0), a2, voffA);
            PG8_WAIT_V(8); PG8_WAIT_L(0); PG8_BAR; PG8_MMA(1, 0, At, B0); PG8_MMA(1, 1, At, B1); PG8_BAR; PG8_SCHED;
            PG8_LDB(B0, 1, 0); PG8_LDB(B1, 1, 1); PG8_SCHED; PG8_LDA(At, 1, 0); PG8_STAGE(PG8_SA(0, 1), a2 + hstep, voffA);
            PG8_WAIT_V(8); PG8_WAIT_L(0); PG8_BAR; PG8_MMA(0, 0, At, B0); PG8_MMA(0, 1, At, B1); PG8_BAR; PG8_SCHED;
            PG8_LDA(At, 1, 1); PG8_STAGE(PG8_SB(1, 0), b3, voffB); PG8_STAGE(PG8_SB(1, 1), b3 + hstep, voffB); PG8_STAGE(PG8_SA(1, 0), a3, voffA);
            PG8_WAIT_V(8); PG8_WAIT_L(0); PG8_BAR; PG8_MMA(1, 0, At, B0); PG8_MMA(1, 1, At, B1); PG8_BAR; PG8_SCHED;
            } else {
            PG8_LDB(B0, 0, 0); PG8_SCHED; PG8_LDA(At, 0, 0); PG8_STAGE(PG8_SA(1, 1), a1 + hstep, voffA);
            PG8_WAIT_L(8); PG8_BAR; PG8_WAIT_L(0); PG8_MMA(0, 0, At, B0); PG8_BAR; PG8_SCHED;
            PG8_LDB(B1, 0, 1); PG8_STAGE(PG8_SB(0, 0), b2, voffB);
            PG8_BAR; PG8_WAIT_L(0); PG8_MMA(0, 1, At, B1); PG8_BAR;
            PG8_LDA(At, 0, 1); PG8_STAGE(PG8_SA(0, 0), a2, voffA);
            PG8_BAR; PG8_WAIT_L(0); PG8_MMA(1, 0, At, B0); PG8_BAR; PG8_SCHED;
            PG8_STAGE(PG8_SB(0, 1), b2 + hstep, voffB);
            PG8_WAIT_V(6); PG8_BAR; PG8_MMA(1, 1, At, B1); PG8_BAR;
            PG8_LDB(B0, 1, 0); PG8_SCHED; PG8_LDA(At, 1, 0); PG8_STAGE(PG8_SA(0, 1), a2 + hstep, voffA);
            PG8_WAIT_L(8); PG8_BAR; PG8_WAIT_L(0); PG8_MMA(0, 0, At, B0); PG8_BAR; PG8_SCHED;
            PG8_LDB(B1, 1, 1); PG8_STAGE(PG8_SB(1, 0), b3, voffB);
            PG8_BAR; PG8_WAIT_L(0); PG8_MMA(0, 1, At, B1); PG8_BAR;
            PG8_LDA(At, 1, 1); PG8_STAGE(PG8_SA(1, 0), a3, voffA);
            PG8_BAR; PG8_WAIT_L(0); PG8_MMA(1, 0, At, B0); PG8_BAR; PG8_SCHED;
            PG8_STAGE(PG8_SB(1, 1), b3 + hstep, voffB);
            PG8_WAIT_V(6); PG8_BAR; PG8_MMA(1, 1, At, B1); PG8_BAR;
            }
        }
        if constexpr (ALIGN_EPI) { if (wr == 0) PG8_BAR; }
        if constexpr (!Epi::AFTER_DRAIN) { const int le_ = fresh_lane(); E(acc, cur, wr, wc, le_ & 15, le_ >> 4); S.done(cur); }
        if (!has_next) break;
#pragma unroll
        for (int a = 0; a < 2; ++a)
#pragma unroll
            for (int b = 0; b < 2; ++b)
#pragma unroll
                for (int m = 0; m < 4; ++m)
#pragma unroll
                    for (int n = 0; n < 2; ++n) acc[a][b][m][n] = (f32x4){zf_, zf_, zf_, zf_};
        cur = nxt; cA = nA; cB = nB; ++ui;
        if constexpr (ALIGN_EPI) { if (wr == 1) PG8_BAR; }
    }
    PG8_WAIT_V(0);
    if constexpr (!ALIGN_EPI) { if (wr == 0) PG8_BAR; }
    PG8_BAR;
    if constexpr (Epi::AFTER_DRAIN) { const int le_ = fresh_lane(); E.fused(acc, cur, wr, wc, le_ & 15, le_ >> 4, lds, wid, le_); S.done(cur); }
#undef PG8_SA
#undef PG8_SB
#undef PG8_STAGE
#undef PG8_LDA
#undef PG8_LDB
#undef PG8_MMA
#undef PG8_WAIT_V
#undef PG8_WAIT_L
#undef PG8_BAR
#undef PG8_SCHED
}
}
#define GAS __attribute__((address_space(1)))
#define LAS __attribute__((address_space(3)))
typedef unsigned short bf16;
typedef unsigned v4u __attribute__((ext_vector_type(4)));
typedef unsigned v2u __attribute__((ext_vector_type(2)));
typedef float f32x4 __attribute__((ext_vector_type(4)));
#define LDS_WAIT() asm volatile("s_waitcnt lgkmcnt(0)" ::: "memory")

constexpr int NWAVES = 8;
constexpr int SEQ = 4096, NB = 4, M = NB * SEQ, D = 2048, DFF = 5632, PLE = 256;
constexpr int AB_IN = 7680, AB_OUT = 1536, CD_IN = 3904, CD_INP = 4160, CD_OUT = 2048;
constexpr int KV_LD = 1088, VTP = M + 64;
constexpr float EPS = 1e-6f;
constexpr size_t MiB = 1u << 20;
constexpr size_t WS_ROPE = 1 * MiB, WS_KMEAN = 4 * MiB;
constexpr size_t WS_WGU = 8 * MiB, WGU_SZ = 44 * MiB, WS_WDN = 184 * MiB, WDN_SZ = 22 * MiB;
constexpr size_t WS_WABIN = 272 * MiB, WS_WABOUT = 302 * MiB, WS_WCDIN = 308 * MiB, WS_WUQ = 324 * MiB, WS_WUKV = 326 * MiB, WS_WCDOUT = 328 * MiB;
constexpr size_t WS_WGATE = 336 * MiB, WGATE_SZ = 8 * MiB, WS_WPROJ = 352 * MiB, WPROJ_SZ = 1 * MiB;
constexpr size_t WS_PB = 354 * MiB, WS_H = 370 * MiB, WS_ACT = 434 * MiB, WS_Z = 610 * MiB, WS_O = 850 * MiB, WS_T = 914 * MiB;
constexpr size_t WS_QC = 978 * MiB, WS_KV = 1026 * MiB, WS_CQN = 1090 * MiB, WS_CKVN = 1106 * MiB;
constexpr size_t WS_VTA = 1114 * MiB, WS_VTB = 1148 * MiB, WS_VTC = 1198 * MiB, WS_VTD = 1232 * MiB, WS_HB = 1266 * MiB, WS_END = 1350 * MiB;
constexpr size_t WS_SS = 1330 * MiB, SS_SITE = (size_t)M * 32;
constexpr int LDS_BYTES = 147456;

__device__ __forceinline__ unsigned f2bf(float f) { unsigned u = __builtin_bit_cast(unsigned, f); return (u + 0x7fffu + ((u >> 16) & 1u)) >> 16; }
__device__ __forceinline__ unsigned pk2(float lo, float hi) { return f2bf(lo) | (f2bf(hi) << 16); }
__device__ __forceinline__ float bflo(unsigned w) { return __uint_as_float(w << 16); }
__device__ __forceinline__ float bfhi(unsigned w) { return __uint_as_float(w & 0xffff0000u); }
__device__ __forceinline__ float shfl_xor_l(float v, int mask, int lane) { return __int_as_float(__builtin_amdgcn_ds_bpermute((lane ^ mask) << 2, __float_as_int(v))); }
__device__ __forceinline__ float wave_sum(float v, int lane) {
#pragma unroll
    for (int o = 1; o < 64; o <<= 1) v += shfl_xor_l(v, o, lane);
    return v;
}
__device__ __forceinline__ float wave_max(float v, int lane) {
#pragma unroll
    for (int o = 1; o < 64; o <<= 1) v = fmaxf(v, shfl_xor_l(v, o, lane));
    return v;
}
__device__ __forceinline__ void half_pair(float v, float& lo, float& hi) { auto rr = __builtin_amdgcn_permlane32_swap(__float_as_uint(v), __float_as_uint(v), false, false); lo = __uint_as_float(rr[0]); hi = __uint_as_float(rr[1]); }
__device__ __forceinline__ float half_sum(float v) { float a, b; half_pair(v, a, b); return a + b; }
__device__ __forceinline__ float half_max(float v) { float a, b; half_pair(v, a, b); return fmaxf(a, b); }

__device__ __forceinline__ int rope_row128(int d) { return 32 * ((d & 63) >> 4) + 8 * (((d & 63) >> 2) & 3) + 4 * (d >> 6) + (d & 3); }
__device__ __forceinline__ int rope_row64(int d) { return 32 * ((d & 31) >> 4) + 8 * (((d & 31) >> 2) & 3) + 4 * (d >> 5) + (d & 3); }
__device__ __forceinline__ void transpose_item(const float* W, int K, int N, bf16* WT, int k0, int n0, int drow0, LAS float* scr, int lane, const float* gain, int rmode = 0) {
    const int c = lane & 7;
    f32x4 g0 = {1.f, 1.f, 1.f, 1.f}, g1 = {1.f, 1.f, 1.f, 1.f};
    if (gain) { g0 = *(const f32x4*)(gain + k0 + 8 * c); g1 = *(const f32x4*)(gain + k0 + 8 * c + 4); }
    float wv[32];
#pragma unroll
    for (int i = 0; i < 32; ++i) { const int kk = 2 * i + (lane >> 5); wv[i] = W[(size_t)(k0 + kk) * N + n0 + (lane & 31)]; }
#pragma unroll
    for (int i = 0; i < 32; ++i) { const int kk = 2 * i + (lane >> 5); scr[kk * 33 + (lane & 31)] = wv[i]; }
    LDS_WAIT(); asm volatile("" ::: "memory");
#pragma unroll
    for (int j = 0; j < 4; ++j) { const int n = (lane >> 3) + 8 * j; const LAS float* s = scr + (8 * c) * 33 + n;
        v4u o; o.x = pk2(s[0 * 33] * g0.x, s[1 * 33] * g0.y); o.y = pk2(s[2 * 33] * g0.z, s[3 * 33] * g0.w); o.z = pk2(s[4 * 33] * g1.x, s[5 * 33] * g1.y); o.w = pk2(s[6 * 33] * g1.z, s[7 * 33] * g1.w);
        const int ng = n0 + n; const int drow = (rmode == 1) ? (ng & ~127) + rope_row128(ng & 127) : (rmode == 2) ? (ng & ~63) + rope_row64(ng & 63) : drow0 + n;
        *(v4u*)(WT + (size_t)drow * K + k0 + 8 * c) = o; }
    LDS_WAIT(); asm volatile("" ::: "memory");
}
__device__ __forceinline__ void conv_matrix(const float* W, int K, int N, bf16* WT, int mode, LAS float* scr, int lane, int gw, int ngw, const float* gain = nullptr) {
    const int nblk = N / 32, items = (K / 64) * nblk;
    for (int it = gw; it < items; it += ngw) {
        const int kb = it / nblk, nb = it % nblk, n0 = 32 * nb; int drow0 = n0;
        if (mode == 1) { const int f = (n0 < DFF) ? n0 : n0 - DFF; drow0 = 256 * (f >> 7) + (f & 127) + ((n0 < DFF) ? 0 : 128); }
        if (mode == 2) { const int hd = n0 >> 8, t = n0 & 255; drow0 = (t < 128) ? hd * 128 + t : 1024 + hd * 128 + (t - 128); }
        int rmode = 0; if (mode == 3) rmode = (n0 < 2048) ? 2 : (n0 >= 3072 && n0 < 6144) ? 1 : 0;
        transpose_item(W, K, N, WT, 64 * kb, n0, drow0, scr, lane, gain, rmode);
    }
}
__device__ __forceinline__ void first_row(const float* xrow, bf16* xb, float* ss, int lane) {
    const f32x4* xr = (const f32x4*)xrow + lane; v2u* o8 = (v2u*)xb + lane;
    f32x4 v[8]; float s = 0.f;
#pragma unroll
    for (int j = 0; j < 8; ++j) { v[j] = xr[64 * j]; s += (v[j].x * v[j].x + v[j].y * v[j].y) + (v[j].z * v[j].z + v[j].w * v[j].w); }
#pragma unroll
    for (int j = 0; j < 8; ++j) { v2u w; w.x = pk2(v[j].x, v[j].y); w.y = pk2(v[j].z, v[j].w); o8[64 * j] = w; }
    s = wave_sum(s, lane);
    if (lane < 32) ss[lane] = (lane == 0) ? s : 0.f;
}
__device__ __forceinline__ void final_norm_row(const bf16* srow, float* orow, const float* gain, float ssv, int lane) {
    const v2u* sr = (const v2u*)srow + lane; f32x4* xr = (f32x4*)orow + lane; const f32x4* gr = (const f32x4*)gain + lane;
    const float rstd = rsqrtf(ssv * (1.f / D) + EPS);
    v2u w[8];
#pragma unroll
    for (int j = 0; j < 8; ++j) w[j] = sr[64 * j];
#pragma unroll
    for (int j = 0; j < 8; ++j) { const f32x4 g = gr[64 * j]; xr[64 * j] = (f32x4){bflo(w[j].x) * rstd * g.x, bfhi(w[j].x) * rstd * g.y, bflo(w[j].y) * rstd * g.z, bfhi(w[j].y) * rstd * g.w}; }
}
__device__ __forceinline__ void rope8(bf16* p, int half, const float* cs, const float* sn) {
    const v4u a = *(const v4u*)p, b = *(const v4u*)(p + half);
    const f32x4 c0 = *(const f32x4*)cs, c1 = *(const f32x4*)(cs + 4), s0 = *(const f32x4*)sn, s1 = *(const f32x4*)(sn + 4);
    float x1[8] = {bflo(a.x), bfhi(a.x), bflo(a.y), bfhi(a.y), bflo(a.z), bfhi(a.z), bflo(a.w), bfhi(a.w)};
    float x2[8] = {bflo(b.x), bfhi(b.x), bflo(b.y), bfhi(b.y), bflo(b.z), bfhi(b.z), bflo(b.w), bfhi(b.w)};
    float c[8] = {c0.x, c0.y, c0.z, c0.w, c1.x, c1.y, c1.z, c1.w}, s[8] = {s0.x, s0.y, s0.z, s0.w, s1.x, s1.y, s1.z, s1.w};
    float y1[8], y2[8];
#pragma unroll
    for (int e = 0; e < 8; ++e) { y1[e] = x1[e] * c[e] - x2[e] * s[e]; y2[e] = x2[e] * c[e] + x1[e] * s[e]; }
    v4u oa, ob;
    oa.x = pk2(y1[0], y1[1]); oa.y = pk2(y1[2], y1[3]); oa.z = pk2(y1[4], y1[5]); oa.w = pk2(y1[6], y1[7]);
    ob.x = pk2(y2[0], y2[1]); ob.y = pk2(y2[2], y2[3]); ob.z = pk2(y2[4], y2[5]); ob.w = pk2(y2[6], y2[7]);
    *(v4u*)p = oa; *(v4u*)(p + half) = ob;
}
__device__ __forceinline__ void small_norm(const bf16* src, int n, const float* gain, bf16* dst, int lane) {
    float s = 0.f; v2u w[2];
    const int nch = n / 256;
#pragma unroll
    for (int j = 0; j < 2; ++j) if (j < nch) { w[j] = *(const v2u*)(src + 4 * (lane + 64 * j)); const float a = bflo(w[j].x), b = bfhi(w[j].x), c = bflo(w[j].y), d = bfhi(w[j].y); s += (a * a + b * b) + (c * c + d * d); }
    const float rstd = rsqrtf(wave_sum(s, lane) / (float)n + EPS);
#pragma unroll
    for (int j = 0; j < 2; ++j) if (j < nch) { const f32x4 g = *(const f32x4*)(gain + 4 * (lane + 64 * j)); v2u o;
        o.x = pk2(bflo(w[j].x) * rstd * g.x, bfhi(w[j].x) * rstd * g.y); o.y = pk2(bflo(w[j].y) * rstd * g.z, bfhi(w[j].y) * rstd * g.w);
        *(v2u*)(dst + 4 * (lane + 64 * j)) = o; }
}

#define XB_TMO      128
#define XB_XCNT(j)  (256  + 64 * (j))
#define XB_XSUB(j)  (1280 + 64 * (j))
#define XB_XGEN(j)  (2304 + 64 * (j))
#define XB_TOP      3328
#define XB_TOPGEN   3392
#define XCD_BAR_WORDS 3456
#define XB_SPIN_CAP (1u << 18)

__device__ __forceinline__ unsigned xb_ld(unsigned* p)              { return __hip_atomic_load(p, __ATOMIC_RELAXED, __HIP_MEMORY_SCOPE_AGENT); }
__device__ __forceinline__ unsigned xb_add(unsigned* p, unsigned v) { return __hip_atomic_fetch_add(p, v, __ATOMIC_RELAXED, __HIP_MEMORY_SCOPE_AGENT); }
__device__ __forceinline__ unsigned xb_xcc_id() { return (unsigned)__builtin_amdgcn_s_getreg((3 << 11) | 20) & 0xFu; }
#define XB_SPIN(cond, bar) do { unsigned _sp = 0; while (cond) { __builtin_amdgcn_s_sleep(1); \
    if ((++_sp & 255u) == 0u) { if (xb_ld(&(bar)[XB_TMO])) break; if (_sp > XB_SPIN_CAP) { atomicAdd(&(bar)[XB_TMO], 1u); break; } } } } while (0)

struct XcdBarrier {
    unsigned* bar; unsigned x;
    volatile LAS unsigned* st;
};

__device__ __forceinline__ XcdBarrier xcd_barrier_post(unsigned* bar, volatile LAS unsigned* st) {
    XcdBarrier b; b.bar = bar; b.x = xb_xcc_id(); b.st = st;
    if (threadIdx.x == 0) (void)xb_add(&bar[XB_XCNT(b.x)], 1u);
    return b;
}
__device__ __forceinline__ void xcd_barrier_complete(unsigned* bar, unsigned x, unsigned& nloc, unsigned& nx) {
    const unsigned G = gridDim.x * gridDim.y * gridDim.z;
    unsigned sum, cnt, mine, sp = 0u;
    for (;;) {
        sum = 0u; cnt = 0u; mine = 0u;
#pragma unroll
        for (unsigned j = 0; j < 16; ++j) { const unsigned c = xb_ld(&bar[XB_XCNT(j)]); sum += c; cnt += (c > 0u) ? 1u : 0u; mine = (j == x) ? c : mine; }
        if (sum == G) break;
        __builtin_amdgcn_s_sleep(1);
        if ((++sp & 255u) == 0u) { if (xb_ld(&bar[XB_TMO])) break; if (sp > XB_SPIN_CAP) { atomicAdd(&bar[XB_TMO], 1u); break; } }
    }
    nloc = mine > 0u ? mine : 1u; nx = cnt > 0u ? cnt : 1u;
}

__device__ __forceinline__ void xcd_barrier(const XcdBarrier& b) {
    asm volatile("s_waitcnt vmcnt(0)" ::: "memory");
    __syncthreads();
    if (threadIdx.x == 0) {
        unsigned* bar = b.bar;
        __builtin_amdgcn_s_waitcnt(0);
        unsigned nloc = b.st[0], nx = b.st[1];
        if (nloc == 0u) { xcd_barrier_complete(bar, b.x, nloc, nx); b.st[0] = nloc; b.st[1] = nx; }
        const unsigned old = xb_add(&bar[XB_XSUB(b.x)], 1u);
        const unsigned gen = old / nloc;
        if (old + 1u == (gen + 1u) * nloc) {
            __builtin_amdgcn_fence(__ATOMIC_RELEASE, "agent");
            asm volatile("s_waitcnt vmcnt(0)" ::: "memory");
            const unsigned og = xb_add(&bar[XB_TOP], 1u);
            const unsigned tg = og / nx;
            if (og + 1u == (tg + 1u) * nx) xb_add(&bar[XB_TOPGEN], 1u);
            else XB_SPIN(xb_ld(&bar[XB_TOPGEN]) == tg, bar);
            __builtin_amdgcn_fence(__ATOMIC_ACQUIRE, "agent");
            xb_add(&bar[XB_XGEN(b.x)], 1u);
            asm volatile("s_waitcnt vmcnt(0)" ::: "memory");
        } else {
            XB_SPIN(xb_ld(&bar[XB_XGEN(b.x)]) == gen, bar);
            __builtin_amdgcn_fence(__ATOMIC_ACQUIRE, "agent");
            asm volatile("s_waitcnt vmcnt(0)" ::: "memory");
        }
    }
    __syncthreads();
}

typedef short bf16x8 __attribute__((ext_vector_type(8)));
typedef float f32x16 __attribute__((ext_vector_type(16)));
#define MFMA32(a, b, c) __builtin_amdgcn_mfma_f32_32x32x16_bf16((a), (b), (c), 0, 0, 0)
__device__ __forceinline__ int crow(int i, int hi) { return (i & 3) + 8 * (i >> 2) + 4 * hi; }
__device__ __forceinline__ unsigned cvtpk(float lo, float hi) { typedef float f2_t __attribute__((ext_vector_type(2))); typedef __bf16 b2_t __attribute__((ext_vector_type(2)));
    f2_t v = {lo, hi}; b2_t b = __builtin_convertvector(v, b2_t); return __builtin_bit_cast(unsigned, b); }

struct CtlCausal { static constexpr bool PAIR = true; int qw, r32, hi; bool moba; int own; unsigned selmask;
    __device__ __forceinline__ bool need(int kv0) const {
        if (kv0 > qw) return false;
        if (!moba) return true;
        const int blk = kv0 >> 8; if (blk == own) return true;
        return __ballot(((selmask >> blk) & 1u) != 0u) != 0ull; }
    __device__ __forceinline__ void mask(f32x16& s, int kv0) const {
        if (kv0 == qw) {
#pragma unroll
            for (int i = 0; i < 16; ++i) if (crow(i, hi) > r32) s[i] = -INFINITY; }
        if (moba) { const int blk = kv0 >> 8; const bool keep = (blk == own) || (((selmask >> blk) & 1u) != 0u);
#pragma unroll
            for (int i = 0; i < 16; ++i) s[i] = keep ? s[i] : -INFINITY; } } };
struct CtlDil { static constexpr bool PAIR = false; int qw, r32, hi, window, dilm1;
    __device__ __forceinline__ bool need(int kv0) const { return (kv0 + 31 >= qw - window) && (kv0 <= qw + 31); }
    __device__ __forceinline__ void mask(f32x16& s, int kv0) const {
        const int d0 = (qw + r32) - kv0 - 4 * hi;
#pragma unroll
        for (int i = 0; i < 16; ++i) { const int dlt = d0 - ((i & 3) + 8 * (i >> 2)); const bool ok = (dlt >= 0) && (dlt <= window) && ((dlt & dilm1) == 0); s[i] = ok ? s[i] : -INFINITY; } } };

__device__ __forceinline__ void att_softmax(f32x16& s, float sc, float& m, float& l, f32x16 (&o)[4], bf16x8& pf0, bf16x8& pf1) {
    float mx = fmaxf(fmaxf(s[0], s[1]), fmaxf(s[2], s[3]));
#pragma unroll
    for (int i = 4; i < 16; i += 4) mx = fmaxf(mx, fmaxf(fmaxf(s[i], s[i + 1]), fmaxf(s[i + 2], s[i + 3])));
    mx = half_max(mx);
    const float mnew = fmaxf(m, mx * sc);
    const float msafe = (mnew == -INFINITY) ? 0.f : mnew;
    const float alpha = __builtin_amdgcn_exp2f(m - msafe);
    m = mnew;
    float rs0 = 0.f, rs1 = 0.f;
#pragma unroll
    for (int i = 0; i < 16; i += 2) { s[i] = __builtin_amdgcn_exp2f(s[i] * sc - msafe); s[i + 1] = __builtin_amdgcn_exp2f(s[i + 1] * sc - msafe); rs0 += s[i]; rs1 += s[i + 1]; }
    l = l * alpha + (rs0 + rs1);
    if (__builtin_amdgcn_ballot_w64(alpha != 1.0f) != 0ull) {
#pragma unroll
        for (int db = 0; db < 4; ++db) o[db] = o[db] * alpha; }
    v4u pw0, pw1;
    pw0.x = cvtpk(s[0], s[1]); pw0.y = cvtpk(s[2], s[3]); pw0.z = cvtpk(s[4], s[5]); pw0.w = cvtpk(s[6], s[7]);
    pw1.x = cvtpk(s[8], s[9]); pw1.y = cvtpk(s[10], s[11]); pw1.z = cvtpk(s[12], s[13]); pw1.w = cvtpk(s[14], s[15]);
    pf0 = __builtin_bit_cast(bf16x8, pw0); pf1 = __builtin_bit_cast(bf16x8, pw1);
}
__device__ __forceinline__ void att_pv(f32x16 (&o)[4], const LAS unsigned char* vb, bf16x8 pf0, bf16x8 pf1) {
#pragma unroll
    for (int s_ = 0; s_ < 2; ++s_)
#pragma unroll
        for (int db = 0; db < 4; ++db) {
            const LAS v2u* p0 = (const LAS v2u*)(vb + db * 32 * 136 + s_ * 32);
            const v2u al = p0[0], ah = p0[2];
            const v4u av = {al.x, al.y, ah.x, ah.y};
            o[db] = MFMA32(__builtin_bit_cast(bf16x8, av), s_ ? pf1 : pf0, o[db]);
        }
}
template <int NC1, int NC2> struct AttnGeom { static constexpr int NC = NC1 + NC2, CPR = 2 * NC, KSTRIDE = CPR * 16 + 16, KBYTES = 64 * KSTRIDE, VSTRIDE = 136, VBYTES = 128 * VSTRIDE, BUF = KBYTES + VBYTES, KCH = CPR / 8; };
template <int NC1, int NC2, class Ctl>
__device__ __forceinline__ void wg_attention(LAS unsigned char* lds, const bf16* k1, int ldk1, const bf16* k2, int ldk2, const bf16* vt, int tok0, int kvpos0, int nstages,
        const bf16x8 (&qf)[NC1 + NC2], float sc, const Ctl& ctl, f32x16 (&o)[4], float& m, float& l, int tid, int r32, int hi) {
    typedef AttnGeom<NC1, NC2> Gm; constexpr int NC = Gm::NC, CPR = Gm::CPR, KCH = Gm::KCH;
    v4u kreg[KCH], vreg[2];
#define WGA_LOAD(tok) do {   \
        const char* kb1_ = (const char*)(k1 + (size_t)(tok) * ldk1); const char* kb2_ = (NC2 > 0) ? (const char*)(k2 + (size_t)(tok) * ldk2) : kb1_; const char* vb_ = (const char*)(vt + (tok)); \
        _Pragma("unroll") for (int i_ = 0; i_ < KCH; ++i_) { const int id_ = tid + 512 * i_, row_ = id_ / CPR, c_ = id_ % CPR; \
            if (NC2 == 0 || c_ < 2 * NC1) kreg[i_] = *(const v4u*)(kb1_ + (size_t)(unsigned)((row_ * ldk1 + c_ * 8) * 2)); \
            else kreg[i_] = *(const v4u*)(kb2_ + (size_t)(unsigned)((row_ * ldk2 + (c_ - 2 * NC1) * 8) * 2)); } \
        _Pragma("unroll") for (int i_ = 0; i_ < 2; ++i_) { const int id_ = tid + 512 * i_, row_ = id_ >> 3, c_ = id_ & 7; vreg[i_] = *(const v4u*)(vb_ + (size_t)(unsigned)((row_ * VTP + c_ * 8) * 2)); } } while (0)
#define WGA_WRITE(buf) do { \
        _Pragma("unroll") for (int i_ = 0; i_ < KCH; ++i_) { const int id_ = tid + 512 * i_, row_ = id_ / CPR, c_ = id_ % CPR; *(LAS v4u*)(lds + (buf) * Gm::BUF + row_ * Gm::KSTRIDE + c_ * 16) = kreg[i_]; } \
        _Pragma("unroll") for (int i_ = 0; i_ < 2; ++i_) { const int id_ = tid + 512 * i_, row_ = id_ >> 3, c_ = id_ & 7; LAS v2u* d_ = (LAS v2u*)(lds + (buf) * Gm::BUF + Gm::KBYTES + row_ * Gm::VSTRIDE + c_ * 16); \
            d_[0] = (v2u){vreg[i_].x, vreg[i_].y}; d_[1] = (v2u){vreg[i_].z, vreg[i_].w}; } } while (0)
    WGA_LOAD(tok0); WGA_WRITE(0);
    __syncthreads();
#pragma unroll 1
    for (int j = 0; j < nstages; ++j) {
        const int buf = j & 1;
        if (j + 1 < nstages) WGA_LOAD(tok0 + 64 * (j + 1));
        const int kvA = kvpos0 + 64 * j, kvB = kvA + 32;
        const bool nA = ctl.need(kvA), nB = ctl.need(kvB);
        const LAS unsigned char* kbase = lds + buf * Gm::BUF + r32 * Gm::KSTRIDE + hi * 16;
        const LAS unsigned char* vbase = lds + buf * Gm::BUF + Gm::KBYTES + r32 * Gm::VSTRIDE + 8 * hi;
        constexpr bool KPRE = (NC <= 8);
        bf16x8 kf[NC];
        if (nA || nB) {
            const int first = nA ? 0 : 1;
#pragma unroll
            for (int c = 0; c < NC; ++c) kf[c] = *(const LAS bf16x8*)(kbase + first * 32 * Gm::KSTRIDE + c * 32);
#pragma unroll
            for (int sb = 0; sb < 2; ++sb) {
                if (!(sb ? nB : nA)) continue;
                if (!KPRE && sb == 1 && nA) {
#pragma unroll
                    for (int c = 0; c < NC; ++c) kf[c] = *(const LAS bf16x8*)(kbase + 32 * Gm::KSTRIDE + c * 32); }
                f32x16 s;
#pragma unroll
                for (int i = 0; i < 16; ++i) s[i] = 0.f;
#pragma unroll
                for (int c = 0; c < NC; ++c) s = MFMA32(kf[c], qf[c], s);
                __builtin_amdgcn_sched_barrier(0);
                v4u av[8];
#pragma unroll
                for (int s_ = 0; s_ < 2; ++s_)
#pragma unroll
                    for (int db = 0; db < 4; ++db) { const LAS v2u* p0 = (const LAS v2u*)(vbase + sb * 64 + db * 32 * 136 + s_ * 32); const v2u al = p0[0], ah = p0[2]; av[s_ * 4 + db] = (v4u){al.x, al.y, ah.x, ah.y}; }
                if (KPRE && sb == 0 && nB) {
#pragma unroll
                    for (int c = 0; c < NC; ++c) kf[c] = *(const LAS bf16x8*)(kbase + 32 * Gm::KSTRIDE + c * 32); }
                __builtin_amdgcn_sched_barrier(0);
                bf16x8 pa0, pa1;
                ctl.mask(s, sb ? kvB : kvA); att_softmax(s, sc, m, l, o, pa0, pa1);
                __builtin_amdgcn_sched_barrier(0);
#pragma unroll
                for (int s_ = 0; s_ < 2; ++s_)
#pragma unroll
                    for (int db = 0; db < 4; ++db) o[db] = MFMA32(__builtin_bit_cast(bf16x8, av[s_ * 4 + db]), s_ ? pa1 : pa0, o[db]);
                __builtin_amdgcn_sched_barrier(0);
            }
        }
        if (j + 1 < nstages) WGA_WRITE(buf ^ 1);
        __syncthreads();
    }
#undef WGA_LOAD
#undef WGA_WRITE
}
template <int NC>
__device__ __forceinline__ void wg_attention128(LAS unsigned char* lds, const bf16* k1, int ldk1, const bf16* vt, int tok0, int nstages,
        const bf16x8 (&qf)[NC], float sc, const CtlCausal& ctl, f32x16 (&o)[4], float& m, float& l, int tid, int r32, int hi) {
    constexpr int CPR = 2 * NC, SK = 128, KSTRIDE = CPR * 16 + 16, KBYTES = SK * KSTRIDE, VSTRIDE = SK * 2 + 8, VBYTES = 128 * VSTRIDE, BUF = KBYTES + VBYTES, KCH = CPR * SK / 512, VCPR = SK / 8, VCH = 128 * VCPR / 512;
    static_assert(2 * BUF <= 143360 - 2048, "two stages must fit below the barrier / stats words at the top of LDS");
    v4u kreg[KCH], vreg[VCH];
#define WGB_LOAD(tok) do { const char* kb1_ = (const char*)(k1 + (size_t)(tok) * ldk1); const char* vb_ = (const char*)(vt + (tok)); \
        _Pragma("unroll") for (int i_ = 0; i_ < KCH; ++i_) { const int id_ = tid + 512 * i_, row_ = id_ / CPR, c_ = id_ % CPR; kreg[i_] = *(const v4u*)(kb1_ + (size_t)(unsigned)((row_ * ldk1 + c_ * 8) * 2)); } \
        _Pragma("unroll") for (int i_ = 0; i_ < VCH; ++i_) { const int id_ = tid + 512 * i_, row_ = id_ / VCPR, c_ = id_ % VCPR; vreg[i_] = *(const v4u*)(vb_ + (size_t)(unsigned)((row_ * VTP + c_ * 8) * 2)); } } while (0)
#define WGB_WRITE(buf) do { \
        _Pragma("unroll") for (int i_ = 0; i_ < KCH; ++i_) { const int id_ = tid + 512 * i_, row_ = id_ / CPR, c_ = id_ % CPR; *(LAS v4u*)(lds + (buf) * BUF + row_ * KSTRIDE + c_ * 16) = kreg[i_]; } \
        _Pragma("unroll") for (int i_ = 0; i_ < VCH; ++i_) { const int id_ = tid + 512 * i_, row_ = id_ / VCPR, c_ = id_ % VCPR; LAS v2u* d_ = (LAS v2u*)(lds + (buf) * BUF + KBYTES + row_ * VSTRIDE + c_ * 16); \
            d_[0] = (v2u){vreg[i_].x, vreg[i_].y}; d_[1] = (v2u){vreg[i_].z, vreg[i_].w}; } } while (0)
#pragma unroll
    for (int c = 0; c < NC; ++c) asm volatile("" :: "v"(qf[c]));
    WGB_LOAD(tok0); WGB_WRITE(0);
    __syncthreads();
#pragma unroll 1
    for (int j = 0; j < nstages; ++j) {
        const int buf = j & 1;
        if (j + 1 < nstages) WGB_LOAD(tok0 + SK * (j + 1));
        const int kvS = SK * j;
        int nn = ((ctl.qw - kvS) >> 5) + 1; nn = nn < 0 ? 0 : (nn > 4 ? 4 : nn);
        if (ctl.moba) { const int blk = kvS >> 8; if (blk != ctl.own && __ballot(((ctl.selmask >> blk) & 1u) != 0u) == 0ull) nn = 0; }
        const LAS unsigned char* kbase = lds + buf * BUF + r32 * KSTRIDE + hi * 16;
        const LAS unsigned char* vbase = lds + buf * BUF + KBYTES + r32 * VSTRIDE + 8 * hi;
        constexpr bool KPRE = (NC <= 4);
        bf16x8 kf[NC];
        if (KPRE && nn > 0) {
#pragma unroll
            for (int c = 0; c < NC; ++c) kf[c] = *(const LAS bf16x8*)(kbase + c * 32);
        }
#pragma unroll 1
        for (int sb = 0; sb < nn; ++sb) {
            if (!KPRE) {
#pragma unroll
                for (int c = 0; c < NC; ++c) kf[c] = *(const LAS bf16x8*)(kbase + sb * 32 * KSTRIDE + c * 32); }
            f32x16 s;
#pragma unroll
            for (int i = 0; i < 16; ++i) s[i] = 0.f;
#pragma unroll
            for (int c = 0; c < NC; ++c) s = MFMA32(kf[c], qf[c], s);
            __builtin_amdgcn_sched_barrier(0);
            v4u av[8];
#pragma unroll
            for (int s_ = 0; s_ < 2; ++s_)
#pragma unroll
                for (int db = 0; db < 4; ++db) { const LAS v2u* p0 = (const LAS v2u*)(vbase + sb * 64 + db * 32 * VSTRIDE + s_ * 32); const v2u al = p0[0], ah = p0[2]; av[s_ * 4 + db] = (v4u){al.x, al.y, ah.x, ah.y}; }
            if (KPRE) { const int sn_ = (sb + 1 < nn) ? sb + 1 : sb;
#pragma unroll
              for (int c = 0; c < NC; ++c) kf[c] = *(const LAS bf16x8*)(kbase + sn_ * 32 * KSTRIDE + c * 32); }
            __builtin_amdgcn_sched_barrier(0);
            bf16x8 pa0, pa1;
            ctl.mask(s, kvS + 32 * sb); att_softmax(s, sc, m, l, o, pa0, pa1);
            __builtin_amdgcn_sched_barrier(0);
#pragma unroll
            for (int s_ = 0; s_ < 2; ++s_)
#pragma unroll
                for (int db = 0; db < 4; ++db) o[db] = MFMA32(__builtin_bit_cast(bf16x8, av[s_ * 4 + db]), s_ ? pa1 : pa0, o[db]);
            __builtin_amdgcn_sched_barrier(0);
        }
        if (j + 1 < nstages) WGB_WRITE(buf ^ 1);
        __syncthreads();
    }
#undef WGB_LOAD
#undef WGB_WRITE
}
__device__ __forceinline__ void rope_frag_pair(bf16x8& a, bf16x8& b, const float* cs, const float* sn) {
    const v4u ua = __builtin_bit_cast(v4u, a), ub = __builtin_bit_cast(v4u, b);
    const f32x4 c0 = *(const f32x4*)cs, c1 = *(const f32x4*)(cs + 4), s0 = *(const f32x4*)sn, s1 = *(const f32x4*)(sn + 4);
    const float x1[8] = {bflo(ua.x), bfhi(ua.x), bflo(ua.y), bfhi(ua.y), bflo(ua.z), bfhi(ua.z), bflo(ua.w), bfhi(ua.w)};
    const float x2[8] = {bflo(ub.x), bfhi(ub.x), bflo(ub.y), bfhi(ub.y), bflo(ub.z), bfhi(ub.z), bflo(ub.w), bfhi(ub.w)};
    const float c[8] = {c0.x, c0.y, c0.z, c0.w, c1.x, c1.y, c1.z, c1.w}, s[8] = {s0.x, s0.y, s0.z, s0.w, s1.x, s1.y, s1.z, s1.w};
    float y1[8], y2[8];
#pragma unroll
    for (int e = 0; e < 8; ++e) { y1[e] = x1[e] * c[e] - x2[e] * s[e]; y2[e] = x2[e] * c[e] + x1[e] * s[e]; }
    v4u oa, ob;
    oa.x = cvtpk(y1[0], y1[1]); oa.y = cvtpk(y1[2], y1[3]); oa.z = cvtpk(y1[4], y1[5]); oa.w = cvtpk(y1[6], y1[7]);
    ob.x = cvtpk(y2[0], y2[1]); ob.y = cvtpk(y2[2], y2[3]); ob.z = cvtpk(y2[4], y2[5]); ob.w = cvtpk(y2[6], y2[7]);
    a = __builtin_bit_cast(bf16x8, oa); b = __builtin_bit_cast(bf16x8, ob);
}
template <int NC>
__device__ __forceinline__ void load_qf(bf16x8 (&qf)[NC], const bf16* qrow, int hi) {
#pragma unroll
    for (int c = 0; c < NC; ++c) qf[c] = *(const bf16x8*)(qrow + 16 * c + 8 * hi);
}
__device__ __forceinline__ void zero_state(f32x16 (&o)[4], float& m, float& l) {
#pragma unroll
    for (int db = 0; db < 4; ++db)
#pragma unroll
        for (int i = 0; i < 16; ++i) o[db][i] = 0.f;
    m = -INFINITY; l = 0.f;
}
__device__ __forceinline__ void store_o(const f32x16 (&o)[4], float l, bf16* orow  , int hi) {
    const float inv = 1.0f / half_sum(l);
#pragma unroll
    for (int db = 0; db < 4; ++db)
#pragma unroll
        for (int ig = 0; ig < 4; ++ig) { v2u w; w.x = cvtpk(o[db][4 * ig] * inv, o[db][4 * ig + 1] * inv); w.y = cvtpk(o[db][4 * ig + 2] * inv, o[db][4 * ig + 3] * inv);
            *(v2u*)(orow + db * 32 + ig * 8 + 4 * hi) = w; }
}
__device__ __forceinline__ void stash_o(const f32x16 (&o)[4], float inv, float* srow, int hi) {
#pragma unroll
    for (int db = 0; db < 4; ++db)
#pragma unroll
        for (int ig = 0; ig < 4; ++ig) *(f32x4*)(srow + db * 32 + ig * 8 + 4 * hi) = (f32x4){o[db][4 * ig] * inv, o[db][4 * ig + 1] * inv, o[db][4 * ig + 2] * inv, o[db][4 * ig + 3] * inv};
}
__device__ __forceinline__ void wg_unit_map(int u, int& bh, int& qb) { const int k = u >> 8, w = u & 255; bh = w >> 3; const int s = w & 7; qb = k ? 15 - s : s; }

#ifndef PROBE_REP_A
#define PROBE_REP_A 1
#endif
#ifndef PROBE_REP_B
#define PROBE_REP_B 1
#endif
#ifndef PROBE_REP_C
#define PROBE_REP_C 1
#endif
#ifndef PROBE_REP_D
#define PROBE_REP_D 1
#endif
struct Args { const float* in[20]; float* out; unsigned char* ws; };

__global__ void __launch_bounds__(NWAVES * 64, 2) mega_fwd(Args args) {
    extern __shared__ __attribute__((aligned(16))) unsigned char lds_raw[];
    cg::grid_group grid = cg::this_grid();
    LAS unsigned char* lds = (LAS unsigned char*)lds_raw;
    typedef const Args __attribute__((address_space(4))) CArgs;
    CArgs* kp = (CArgs*)__builtin_amdgcn_kernarg_segment_ptr();
#define X    (ap->out)
#define H    ((bf16*)(ap->ws + (layer ? WS_HB : WS_H)))
#define HOTHER ((bf16*)(ap->ws + (layer ? WS_H : WS_HB)))
#define ACT  ((bf16*)(ap->ws + WS_ACT))
#define Z    ((bf16*)(ap->ws + WS_Z))
#define O    ((bf16*)(ap->ws + WS_O))
#define T    ((bf16*)(ap->ws + WS_T))
#define QC   ((bf16*)(ap->ws + WS_QC))
#define KV   ((bf16*)(ap->ws + WS_KV))
#define CQN  ((bf16*)(ap->ws + WS_CQN))
#define CKVN ((bf16*)(ap->ws + WS_CKVN))
#define PB   ((bf16*)(ap->ws + WS_PB))
#define cos64  ((float*)(ap->ws + WS_ROPE))
#define sin64  (cos64 + SEQ * 32)
#define cos128 (sin64 + SEQ * 32)
#define sin128 (cos128 + SEQ * 64)
#define KMEAN ((float*)(ap->ws + WS_KMEAN))
#define wl ((LAS float*)(lds + wave * 16384))
    volatile LAS unsigned* bst = (volatile LAS unsigned*)(lds + LDS_BYTES - 64);
    if (threadIdx.x == 0) { bst[0] = 0u; bst[1] = 0u; *(volatile LAS int*)(lds + LDS_BYTES - 4096 + 1024) = -1; }
    if (blockIdx.x == 0) { unsigned* bw = (unsigned*)args.ws; for (int i = threadIdx.x; i < XCD_BAR_WORDS; i += NWAVES * 64) bw[i] = 0u; }
    __syncthreads();
    int wavev = __builtin_amdgcn_readfirstlane(threadIdx.x >> 6), Gv = gridDim.x, bxv = blockIdx.x;
    constexpr int NSTEPS = 20;
    int rep_ = 0;
#pragma unroll 1
    for (int step = 0; step <= NSTEPS - 1; ) {
        unsigned ones_ = ~0u; asm volatile("" : "+s"(kp), "+s"(wavev), "+s"(Gv), "+s"(bxv), "+s"(ones_)); CArgs* ap = kp;
        const int lane = (int)__builtin_amdgcn_mbcnt_hi(ones_, __builtin_amdgcn_mbcnt_lo(ones_, 0u)), wave = wavev, tid = wave * 64 + lane;
        const int G = Gv, bx = bxv;
        const int gw = bx * NWAVES + wave, ngw = G * NWAVES;
        const int vcu = (G % 8 == 0) ? (bx % 8) * (G / 8) + bx / 8 : bx;
        const int layer = (step >= 9) ? 1 : 0;
        const int ls = (step == 0) ? -1 : (layer ? step - 9 : step - 1);
        int code;
        int sub = 0;
        if (step == 0) code = 0;
        else if (layer == 0) {
            switch (ls) { case 0: code = 1; sub = 0; break; case 1: code = 2; sub = 0; break; case 2: code = 4; break; case 3: code = 6; break;
                case 4: code = 7; break; case 5: code = 1; sub = 1; break; case 6: code = 2; sub = 1; break; default: code = 9; break; }
        } else {
            switch (ls) { case 0: code = 1; sub = 0; break; case 1: code = 2; sub = 0; break; case 2: code = 10; break; case 3: code = 11; break; case 4: code = 12; break;
                case 5: code = 14; break; case 6: code = 7; break; case 7: code = 1; sub = 1; break; case 8: code = 2; sub = 1; break; case 9: code = 9; break; default: code = 15; break; }
        }
        code = __builtin_amdgcn_readfirstlane(code); sub = __builtin_amdgcn_readfirstlane(sub);
        float* SS = (float*)(ap->ws + WS_SS);

        if (code == 0) {
            LAS float* scr = wl;
            for (int i = 0; i < 2; ++i) for (int j = 0; j < 2; ++j) {
                conv_matrix(ap->in[3] + (size_t)(i * 2 + j) * D * 2 * DFF, D, 2 * DFF, (bf16*)(ap->ws + WS_WGU + (size_t)(i * 2 + j) * WGU_SZ), 1, scr, lane, gw, ngw, ap->in[2] + (size_t)(i * 2 + j) * D);
                conv_matrix(ap->in[4] + (size_t)(i * 2 + j) * DFF * D, DFF, D, (bf16*)(ap->ws + WS_WDN + (size_t)(i * 2 + j) * WDN_SZ), 0, scr, lane, gw, ngw);
            }
            conv_matrix(ap->in[6], D, AB_IN, (bf16*)(ap->ws + WS_WABIN), 3, scr, lane, gw, ngw, ap->in[5]);
            conv_matrix(ap->in[9], AB_OUT, D, (bf16*)(ap->ws + WS_WABOUT), 0, scr, lane, gw, ngw);
            conv_matrix(ap->in[10], D, CD_IN, (bf16*)(ap->ws + WS_WCDIN), 0, scr, lane, gw, ngw, ap->in[5] + D);
            conv_matrix(ap->in[12], 512, 1536, (bf16*)(ap->ws + WS_WUQ), 0, scr, lane, gw, ngw);
            conv_matrix(ap->in[14], 256, 2048, (bf16*)(ap->ws + WS_WUKV), 2, scr, lane, gw, ngw);
            conv_matrix(ap->in[15], CD_OUT, D, (bf16*)(ap->ws + WS_WCDOUT), 0, scr, lane, gw, ngw);
            for (int i = 0; i < 2; ++i) {
                conv_matrix(ap->in[17] + (size_t)i * D * D, D, D, (bf16*)(ap->ws + WS_WGATE + (size_t)i * WGATE_SZ), 0, scr, lane, gw, ngw, ap->in[16] + (size_t)i * D);
                conv_matrix(ap->in[18] + (size_t)i * PLE * D, PLE, D, (bf16*)(ap->ws + WS_WPROJ + (size_t)i * WPROJ_SZ), 0, scr, lane, gw, ngw);
            }
            {
                const f32x4* ps = (const f32x4*)ap->in[1]; v2u* pd = (v2u*)PB; const int n4 = 2 * M * PLE / 4;
                for (int i = gw * 64 + lane; i < n4; i += ngw * 64) { const f32x4 v = ps[i]; v2u w; w.x = pk2(v.x, v.y); w.y = pk2(v.z, v.w); pd[i] = w; }
            }
            {
                for (int i = gw * 64 + lane; i < SEQ * 96; i += ngw * 64) {
                    int pos, k, dim; float *cd, *sd;
                    if (i < SEQ * 32) { pos = i >> 5; k = i & 31; dim = 64; cd = cos64 + i; sd = sin64 + i; }
                    else { const int i2 = i - SEQ * 32; pos = i2 >> 6; k = i2 & 63; dim = 128; cd = cos128 + i2; sd = sin128 + i2; }
                    const float inv = exp2f(-(float)(2 * k) / (float)dim * 13.287712379549449f);
                    const float ang = (float)pos * inv;
                    double rev = (double)ang * 0.15915494309189535; rev -= floor(rev);
                    const float rf = (float)rev;
                    *cd = __builtin_amdgcn_cosf(rf); *sd = __builtin_amdgcn_sinf(rf);
                }
            }
            for (int m = gw; m < M; m += ngw) first_row(ap->in[0] + (size_t)m * D, (bf16*)(ap->ws + WS_H) + (size_t)m * D, SS + (size_t)m * 32, lane);
        } else if (code == 1) {
            pg8::Gemm g{H, (const bf16*)(ap->ws + WS_WGU + (size_t)(layer * 2 + sub) * WGU_SZ), M, 2 * DFF, D}; pg8::StaticOrder S; S.init(M, 2 * DFF, G, bx);
            pg8::EpiSwiGLU E{ACT, DFF, SS + (size_t)(4 * layer + 2 * sub) * SS_SITE};
            pg8::gemm_phase<pg8::EpiSwiGLU, pg8::StaticOrder, true, true>(lds, g, S, E, wave);
        } else if (code == 2 || code == 7) {
            const bf16* A; const bf16* Bt; int K; float alpha; int sidx;
            if (code == 2) { A = ACT; Bt = (const bf16*)(ap->ws + WS_WDN + (size_t)(layer * 2 + sub) * WDN_SZ); K = DFF; alpha = 0.5f; sidx = 4 * layer + (sub ? 3 : 1); }
            else if (layer == 0) { A = O; Bt = (const bf16*)(ap->ws + WS_WABOUT); K = AB_OUT; alpha = 1.0f; sidx = 2; }
            else { A = O; Bt = (const bf16*)(ap->ws + WS_WCDOUT); K = CD_OUT; alpha = 1.0f; sidx = 6; }
            pg8::Gemm g{A, Bt, M, D, K}; pg8::StaticOrder S; S.init(M, D, G, bx);
            pg8::EpiResidual E{H, SS + (size_t)sidx * SS_SITE, D, alpha};
            pg8::gemm_phase<pg8::EpiResidual, pg8::StaticOrder, true, true>(lds, g, S, E, wave);
        } else if (code == 4 || code == 10 || code == 12) {
            __syncthreads();
            if (code == 4) {
                { pg8::Gemm g{H, (const bf16*)(ap->ws + WS_WABIN), M, 2048, D}; pg8::StaticOrder S; S.init(M, 2048, G, bx); pg8::EpiRope E{Z, AB_IN, SS + (size_t)1 * SS_SITE, cos64, sin64, 32};
                  pg8::gemm_phase<pg8::EpiRope, pg8::StaticOrder, true, true>(lds, g, S, E, wave); }
                __syncthreads();
                { pg8::Gemm g{H, (const bf16*)(ap->ws + WS_WABIN) + (size_t)3072 * D, M, 3072, D}; pg8::StaticOrder S; S.init(M, 3072, G, bx); pg8::EpiRope E{Z + 3072, AB_IN, SS + (size_t)1 * SS_SITE, cos128, sin128, 64};
                  pg8::gemm_phase<pg8::EpiRope, pg8::StaticOrder, true, true>(lds, g, S, E, wave); }
                __syncthreads();
                { pg8::Gemm g2{(const bf16*)(ap->ws + WS_WABIN) + (size_t)2048 * D, H, 1024, M, D}; pg8::StaticOrder S2; S2.init(1024, M, G, bx); pg8::EpiStore E2{(bf16*)(ap->ws + WS_VTA), VTP, nullptr, SS + (size_t)1 * SS_SITE};
                  pg8::gemm_phase<pg8::EpiStore, pg8::StaticOrder, true, true>(lds, g2, S2, E2, wave); }
                __syncthreads();
                { pg8::Gemm g2{(const bf16*)(ap->ws + WS_WABIN) + (size_t)6144 * D, H, 1536, M, D}; pg8::StaticOrder S2; S2.init(1536, M, G, bx); pg8::EpiStore E2{(bf16*)(ap->ws + WS_VTB), VTP, nullptr, SS + (size_t)1 * SS_SITE};
                  pg8::gemm_phase<pg8::EpiStore, pg8::StaticOrder, true, true>(lds, g2, S2, E2, wave); } }
            else if (code == 10) { pg8::Gemm g{H, (const bf16*)(ap->ws + WS_WCDIN), M, 3072, D}; pg8::StaticOrder S; S.init(M, 3072, G, bx); pg8::EpiStore E{Z, CD_INP, SS + (size_t)5 * SS_SITE, nullptr};
                pg8::gemm_phase<pg8::EpiStore, pg8::StaticOrder, true, true>(lds, g, S, E, wave);
                __syncthreads();
                { pg8::Gemm g2{(const bf16*)(ap->ws + WS_WCDIN) + (size_t)2880 * D, H, 1024, M, D}; pg8::StaticOrder S2; S2.init(1024, M, G, bx); pg8::EpiStore E2{(bf16*)(ap->ws + WS_VTD), VTP, nullptr, SS + (size_t)5 * SS_SITE};
                  pg8::gemm_phase<pg8::EpiStore, pg8::StaticOrder, true, true>(lds, g2, S2, E2, wave); } }
            else {
                for (int j = gw; j < NB * 8 * 16; j += ngw) {
                const int blk = j & 15, h = (j >> 4) & 7, b = j >> 7;
                const bf16* kp = Z + (size_t)(b * SEQ + blk * 256) * CD_INP + 1856 + h * 128 + 2 * lane; float s0 = 0.f, s1 = 0.f;
#pragma unroll 16
                for (int t = 0; t < 256; ++t) { const unsigned w = *(const unsigned*)(kp + (size_t)t * CD_INP); s0 += bflo(w); s1 += bfhi(w); }
                KMEAN[(size_t)j * 128 + 2 * lane] = s0 * (1.f / 256.f); KMEAN[(size_t)j * 128 + 2 * lane + 1] = s1 * (1.f / 256.f);
            }
                __syncthreads();
                { pg8::Gemm g{CQN, (const bf16*)(ap->ws + WS_WUQ), M, 1536, 512}; pg8::StaticOrder S; S.init(M, 1536, G, bx); pg8::EpiStore E{QC, 1536, nullptr, nullptr};
                  pg8::gemm_phase<pg8::EpiStore, pg8::StaticOrder, true, true>(lds, g, S, E, wave); }
                __syncthreads();
                { pg8::Gemm g{CKVN, (const bf16*)(ap->ws + WS_WUKV), M, 1024, 256}; pg8::StaticOrder S; S.init(M, 1024, G, bx); pg8::EpiStore E{KV, KV_LD, nullptr, nullptr};
                  pg8::gemm_phase<pg8::EpiStore, pg8::StaticOrder, true, true>(lds, g, S, E, wave); }
                __syncthreads();
                { pg8::Gemm g2{(const bf16*)(ap->ws + WS_WUKV) + (size_t)1024 * 256, CKVN, 1024, M, 256}; pg8::StaticOrder S2; S2.init(1024, M, G, bx); pg8::EpiStore E2{(bf16*)(ap->ws + WS_VTC), VTP, nullptr, nullptr};
                  pg8::gemm_phase<pg8::EpiStore, pg8::StaticOrder, true, true>(lds, g2, S2, E2, wave); }
            }
        } else if (code == 9) {
            { pg8::Gemm g{PB + (size_t)layer * M * PLE, (const bf16*)(ap->ws + WS_WPROJ + (size_t)layer * WPROJ_SZ), M, D, PLE}; pg8::StaticOrder S; S.init(M, D, G, bx); pg8::EpiStore E{T, D, nullptr, nullptr};
              pg8::gemm_phase<pg8::EpiStore, pg8::StaticOrder, true, true>(lds, g, S, E, wave); }
            __syncthreads();
            { pg8::Gemm g{H, (const bf16*)(ap->ws + WS_WGATE + (size_t)layer * WGATE_SZ), M, D, D}; pg8::StaticOrder S; S.init(M, D, G, bx); pg8::EpiGate E{H, T, HOTHER, SS + (size_t)(4 * layer + 4) * SS_SITE, SS + (size_t)(4 * layer + 3) * SS_SITE, D};
              pg8::gemm_phase<pg8::EpiGate, pg8::StaticOrder, true, true>(lds, g, S, E, wave); }
        } else if (code == 5) {
            for (int m = gw; m < M; m += ngw) {
                const int pos = m & (SEQ - 1); bf16* zr = Z + (size_t)m * AB_IN;
#pragma unroll
                for (int ch = lane; ch < 128; ch += 64) { const int grp = ch >> 2, c8 = (ch & 3) * 8; rope8(zr + grp * 64 + c8, 32, cos64 + pos * 32 + c8, sin64 + pos * 32 + c8); }
#pragma unroll
                for (int ch = lane; ch < 192; ch += 64) { const int hd = ch >> 3, c8 = (ch & 7) * 8; rope8(zr + 3072 + hd * 128 + c8, 64, cos128 + pos * 64 + c8, sin128 + pos * 64 + c8); }
            }
        } else if (code == 11) {
            for (int m = gw; m < M; m += ngw) {
                const int pos = m & (SEQ - 1); bf16* zr = Z + (size_t)m * CD_INP;
                small_norm(zr, 512, ap->in[11], CQN + (size_t)m * 512, lane);
                small_norm(zr + 512, 256, ap->in[13], CKVN + (size_t)m * 256, lane);
                if (lane < 4) { const int c8 = lane * 8; rope8(zr + 768 + c8, 32, cos64 + pos * 32 + c8, sin64 + pos * 32 + c8); }
#pragma unroll
                for (int ch = lane; ch < 128; ch += 64) { const int hd = ch >> 3, c8 = (ch & 7) * 8; rope8(zr + 832 + hd * 128 + c8, 64, cos128 + pos * 64 + c8, sin128 + pos * 64 + c8); }
            }
        } else if (code == 6) {
            const float lamA = wave_sum(ap->in[7][lane] * ap->in[7][64 + lane], lane), lamB = wave_sum(ap->in[7][128 + lane] * ap->in[7][192 + lane], lane);
            const float lam = __expf(lamA) - __expf(lamB) + 0.2f;
            const int r32 = lane & 31, hi = lane >> 5;
            float* STASH = (float*)(ap->ws + WS_T);
#pragma unroll 1
            for (int u_ = vcu; u_ < 512 * PROBE_REP_A; u_ += G) { const int u = u_ & 511;
                int bh, qb; wg_unit_map(u, bh, qb);
                const int b = bh >> 3, h = bh & 7, tokb = b * SEQ, q0 = qb * 256, qw = q0 + 32 * wave;
                const bf16* vt = (const bf16*)(ap->ws + WS_VTA) + (size_t)(h * 128) * VTP;
                f32x16 o[4]; float m_, l_;
#pragma unroll 1
                for (int mp = 0; mp < 2; ++mp) {
                    bf16x8 qf[4]; load_qf<4>(qf, Z + (size_t)(tokb + qw + r32) * AB_IN + h * 128 + mp * 64, hi);
                    zero_state(o, m_, l_);
                    CtlCausal ctl{qw, r32, hi, false, 0, 0u};
                    wg_attention128<4>(lds, Z + 1024 + h * 128 + mp * 64, AB_IN, vt, tokb, (q0 + 256) >> 7, qf, 0.125f * 1.4426950408889634f, ctl, o, m_, l_, tid, r32, hi);
                    const float inv = 1.0f / half_sum(l_);
                    float* srow = STASH + (size_t)(tokb + qw + r32) * 1024 + h * 128;
                    if (mp == 0) stash_o(o, inv, srow, hi);
                    else {
                        float ss = 0.f;
#pragma unroll
                        for (int db = 0; db < 4; ++db)
#pragma unroll
                            for (int ig = 0; ig < 4; ++ig) { const f32x4 o1 = *(const f32x4*)(srow + db * 32 + ig * 8 + 4 * hi);
#pragma unroll
                                for (int e = 0; e < 4; ++e) { const float a = o1[e] - lam * (o[db][4 * ig + e] * inv); o[db][4 * ig + e] = a; ss += a * a; } }
                        ss = half_sum(ss);
                        const float rstd = rsqrtf(ss * (1.f / 128.f) + EPS) * 0.8f;
                        bf16* orow = O + (size_t)(tokb + qw + r32) * AB_OUT + h * 128;
#pragma unroll
                        for (int db = 0; db < 4; ++db)
#pragma unroll
                            for (int ig = 0; ig < 4; ++ig) { const f32x4 gn = *(const f32x4*)(ap->in[8] + db * 32 + ig * 8 + 4 * hi); v2u w;
                                w.x = cvtpk(o[db][4 * ig] * rstd * gn.x, o[db][4 * ig + 1] * rstd * gn.y); w.y = cvtpk(o[db][4 * ig + 2] * rstd * gn.z, o[db][4 * ig + 3] * rstd * gn.w);
                                *(v2u*)(orow + db * 32 + ig * 8 + 4 * hi) = w; }
                    }
                }
            }
#pragma unroll 1
            for (int u_ = vcu; u_ < 256 * PROBE_REP_B; u_ += G) { const int u = u_ & 255;
                const int b = u >> 6, hh = (u >> 4) & 3, qb = u & 15, tokb = b * SEQ, q0 = qb * 256, qw = q0 + 32 * wave;
                f32x16 o[4]; float m_, l_; zero_state(o, m_, l_);
#pragma unroll 1
                for (int g = 0; g < 3; ++g) {
                    const int hd = g * 4 + hh, dil = 1 << (2 * g), window = 128 << (2 * g);
                    const int kvs = (q0 > window) ? q0 - window : 0, nst = (q0 + 256 - kvs) >> 6;
                    bf16x8 qf[8]; load_qf<8>(qf, Z + (size_t)(tokb + qw + r32) * AB_IN + 3072 + hd * 128, hi);
                    CtlDil ctl{qw, r32, hi, window, dil - 1};
                    wg_attention<8, 0, CtlDil>(lds, Z + 4608 + hd * 128, AB_IN, nullptr, 0, (const bf16*)(ap->ws + WS_VTB) + (size_t)(hd * 128) * VTP, tokb + kvs, kvs, nst, qf, 0.08838834764831845f * 1.4426950408889634f, ctl, o, m_, l_, tid, r32, hi);
                }
                store_o(o, l_, O + (size_t)(tokb + qw + r32) * AB_OUT + 1024 + hh * 128, hi);
            }
        } else if (code == 14) {
#pragma unroll 1
            for (int u_ = vcu; u_ < 512 * PROBE_REP_C; u_ += G) { const int u = u_ & 511;
                int bh, qb; wg_unit_map(u, bh, qb);
                const int ln_ = pg8::fresh_lane(), r32 = ln_ & 31, hi = ln_ >> 5, tid = wave * 64 + ln_;
                const int b = bh >> 3, h = bh & 7, tokb = b * SEQ, q0 = qb * 256, qw = q0 + 32 * wave;
                bf16x8 qf[12]; load_qf<12>(qf, QC + (size_t)(tokb + qw + r32) * 1536 + h * 192, hi);
                { const int pos = qw + r32;
                  rope_frag_pair(qf[8], qf[10], cos64 + pos * 32 + 8 * hi, sin64 + pos * 32 + 8 * hi); rope_frag_pair(qf[9], qf[11], cos64 + pos * 32 + 16 + 8 * hi, sin64 + pos * 32 + 16 + 8 * hi); }
                f32x16 o[4]; float m_, l_; zero_state(o, m_, l_);
                CtlCausal ctl{qw, r32, hi, false, 0, 0u};
                wg_attention<8, 4, CtlCausal>(lds, KV + h * 128, KV_LD, Z + 768, CD_INP, (const bf16*)(ap->ws + WS_VTC) + (size_t)(h * 128) * VTP, tokb, 0, (q0 + 256) >> 6, qf, 0.07216878364870322f * 1.4426950408889634f, ctl, o, m_, l_, tid, r32, hi);
                store_o(o, l_, O + (size_t)(tokb + qw + r32) * CD_OUT + h * 128, hi);
            }
#pragma unroll 1
            for (int u_ = vcu; u_ < 512 * PROBE_REP_D; u_ += G) { const int u = u_ & 511;
                int bh, qb; wg_unit_map(u, bh, qb);
                const int ln_ = pg8::fresh_lane(), r32 = ln_ & 31, hi = ln_ >> 5, tid = wave * 64 + ln_;
                const int b = bh >> 3, h = bh & 7, tokb = b * SEQ, q0 = qb * 256, qw = q0 + 32 * wave, own = qb;
                const bf16* qrow = Z + (size_t)(tokb + qw + r32) * CD_INP + 832 + h * 128;
                float g8[8];
#pragma unroll
                for (int j = 0; j < 8; ++j) g8[j] = 0.f;
                const float* km = KMEAN + (size_t)((b * 8 + h) * 16 + 8 * hi) * 128;
#pragma unroll 2
                for (int d0 = 0; d0 < 128; d0 += 8) {
                    const v4u qw4 = *(const v4u*)(qrow + d0);
                    const float q8[8] = {bflo(qw4.x), bfhi(qw4.x), bflo(qw4.y), bfhi(qw4.y), bflo(qw4.z), bfhi(qw4.z), bflo(qw4.w), bfhi(qw4.w)};
#pragma unroll
                    for (int j = 0; j < 8; ++j) { const f32x4 k0 = *(const f32x4*)(km + j * 128 + d0), k1 = *(const f32x4*)(km + j * 128 + d0 + 4);
                        g8[j] += q8[0] * k0.x + q8[1] * k0.y + q8[2] * k0.z + q8[3] * k0.w + q8[4] * k1.x + q8[5] * k1.y + q8[6] * k1.z + q8[7] * k1.w; }
                }
                float G16[16];
#pragma unroll
                for (int j = 0; j < 8; ++j) { float glo, ghi; half_pair(g8[j], glo, ghi); G16[j] = glo; G16[8 + j] = ghi; }
#pragma unroll
                for (int n = 0; n < 16; ++n) G16[n] = (n < own) ? G16[n] : -INFINITY;
                unsigned selmask = 0u;
#pragma unroll
                for (int k = 0; k < 3; ++k) { float best = -INFINITY; int bi = -1;
#pragma unroll
                    for (int n = 0; n < 16; ++n) if (G16[n] > best) { best = G16[n]; bi = n; }
                    if (bi >= 0) selmask |= 1u << bi;
#pragma unroll
                    for (int n = 0; n < 16; ++n) G16[n] = (n == bi) ? -INFINITY : G16[n]; }
                bf16x8 qf[8]; load_qf<8>(qf, qrow, hi);
                f32x16 o[4]; float m_, l_; zero_state(o, m_, l_);
                CtlCausal ctl{qw, r32, hi, true, own, selmask};
                wg_attention128<8>(lds, Z + 1856 + h * 128, CD_INP, (const bf16*)(ap->ws + WS_VTD) + (size_t)(h * 128) * VTP, tokb, (q0 + 256) >> 7, qf, 0.08838834764831845f * 1.4426950408889634f, ctl, o, m_, l_, tid, r32, hi);
                store_o(o, l_, O + (size_t)(tokb + qw + r32) * CD_OUT + 1024 + h * 128, hi);
            }
        } else {
            for (int m = gw; m < M; m += ngw) { const float sv = (lane < 32) ? SS[(size_t)8 * SS_SITE + (size_t)m * 32 + lane] : 0.f; final_norm_row((const bf16*)(ap->ws + WS_H) + (size_t)m * D, X + (size_t)m * D, ap->in[19], wave_sum(sv, lane), lane); }
        }
#ifdef PROBE_DUP_MASK
        if (((PROBE_DUP_MASK >> code) & 1u) && rep_ == 0) { rep_ = 1; __syncthreads(); continue; }
        rep_ = 0;
#endif
        if (step == 0) { grid.sync(); (void)xcd_barrier_post((unsigned*)ap->ws, bst); }
        else if (step != NSTEPS - 1) { XcdBarrier xb; xb.bar = (unsigned*)ap->ws; xb.x = xb_xcc_id(); xb.st = bst; xcd_barrier(xb); }

        ++step;
    }
}

#undef X
#undef H
#undef HOTHER
#undef ACT
#undef Z
#undef O
#undef T
#undef QC
#undef KV
#undef CQN
#undef CKVN
#undef PB
#undef cos64
#undef sin64
#undef cos128
#undef sin128
#undef KMEAN
#undef wl
extern "C" void kernel_launch(void* const* d_in, const int* in_sizes, int n_in, void* d_out, int out_size, void* d_ws, size_t ws_size, hipStream_t stream) {
    static int grid = 0;
    if (grid == 0) {
        if (n_in != 20 || out_size != M * D || ws_size < WS_END) { fprintf(stderr, "kernel_launch: unexpected problem (n_in %d, out %d, ws %zu)\n", n_in, out_size, ws_size); grid = -1; return; }
        int dev = 0, cus = 0, per_cu = 0;
        hipGetDevice(&dev); hipDeviceGetAttribute(&cus, hipDeviceAttributeMultiprocessorCount, dev);
        if (hipFuncSetAttribute((const void*)mega_fwd, hipFuncAttributeMaxDynamicSharedMemorySize, LDS_BYTES) != hipSuccess) { fprintf(stderr, "kernel_launch: hipFuncSetAttribute failed\n"); grid = -1; return; }
        if (hipOccupancyMaxActiveBlocksPerMultiprocessor(&per_cu, (const void*)mega_fwd, NWAVES * 64, LDS_BYTES) != hipSuccess || per_cu < 1) { fprintf(stderr, "kernel_launch: occupancy query says %d\n", per_cu); per_cu = 1; }
        (void)hipGetLastError();
        grid = cus * 1;
    }
    if (grid < 0) return;
    Args a{};
    for (int i = 0; i < 20; ++i) a.in[i] = (const float*)d_in[i];
    a.out = (float*)d_out; a.ws = (unsigned char*)d_ws;
    void* kargs[] = {&a};
    hipError_t e = hipLaunchCooperativeKernel((const void*)mega_fwd, dim3(grid), dim3(NWAVES * 64), kargs, LDS_BYTES, stream);
    if (e != hipSuccess) fprintf(stderr, "cooperative launch failed: %s (grid %d)\n", hipGetErrorString(e), grid);
}
```
